# Optimizing an MI355X kernel written in HIP

```python
import math
import jax, jax.numpy as jnp
from jax import lax
import numpy as np

D_MODEL = 1024
BATCH = 8
SEQ = 2048
DEPTH = 4

HG_HEADS = 4
HG_DK = 128
HG_DV = 128
HG_K = HG_HEADS * HG_DK
HG_V = HG_HEADS * HG_DV
HG_CHUNK = 64
SG_GROUPS = 4
SG_WIDTH = 512
SG_GROUP_DIM = SG_WIDTH // SG_GROUPS
SG_CHUNK = 128
D_FF = 2816
ALPHA = (2 * DEPTH) ** 0.25
BETA = (8 * DEPTH) ** -0.25
LN_EPS = 1e-5
RMS_EPS = 1e-6
D_IN = 2 * HG_K + 2 * HG_V + 2 * SG_WIDTH + 2 * D_MODEL
IN_SPLITS = (HG_K,
             2 * HG_K,
             2 * HG_K + HG_V,
             2 * HG_K + 2 * HG_V,
             2 * HG_K + 2 * HG_V + SG_WIDTH,
             2 * HG_K + 2 * HG_V + 2 * SG_WIDTH,
             2 * HG_K + 2 * HG_V + 2 * SG_WIDTH + D_MODEL)

kernel_name = "hgrn2_sgu_macaron_deepnorm_hybrid"


def layer_norm(x, g, b):
    xf = x.astype(jnp.float32)
    mu = jnp.mean(xf, axis=-1, keepdims=True)
    var = jnp.mean(jnp.square(xf - mu), axis=-1, keepdims=True)
    y = (xf - mu) * lax.rsqrt(var + LN_EPS) * g.astype(jnp.float32) + b.astype(jnp.float32)
    return y.astype(x.dtype)


def swiglu(x, w13, w2):
    a, b = jnp.split(x @ w13, 2, axis=-1)
    return (jax.nn.silu(a) * b) @ w2


def hgrn2_chunkwise(q, k, i, log_f):
    B, T, H, _ = q.shape
    n_chunks = T // HG_CHUNK

    def to_chunks(a):
        return a.reshape(B, n_chunks, HG_CHUNK, H, a.shape[-1]).transpose(1, 0, 3, 2, 4)

    causal = jnp.tril(jnp.ones((HG_CHUNK, HG_CHUNK), dtype=bool))[:, :, None]

    def step(S, inp):
        q_c, k_c, i_c, lf_c = inp
        b = jnp.cumsum(lf_c, axis=-2)
        o_inter = jnp.einsum('bhtk,bhkv->bhtv', q_c * jnp.exp(b), S)
        diff = b[:, :, :, None, :] - b[:, :, None, :, :]
        decay = jnp.where(causal, jnp.exp(jnp.where(causal, diff, 0.0)), 0.0)
        scores = jnp.einsum('bhtk,bhtsk,bhsk->bhts', q_c, decay, k_c)
        o_intra = jnp.einsum('bhts,bhsv->bhtv', scores, i_c)
        b_last = b[:, :, -1:, :]
        S_new = jnp.exp(b_last[:, :, 0, :])[..., None] * S + jnp.einsum(
            'bhsk,bhsv->bhkv', k_c * jnp.exp(b_last - b), i_c)
        return S_new, o_inter + o_intra

    S0 = jnp.zeros((B, H, q.shape[-1], i.shape[-1]), jnp.float32)
    _, o = lax.scan(step, S0, (to_chunks(q), to_chunks(k), to_chunks(i), to_chunks(log_f)))
    return o.transpose(1, 0, 3, 2, 4).reshape(B, T, H, i.shape[-1])


def mixer(x, w_in, lb, hg_norm_g, sg_ln_g, sg_ln_b, sg_ws, sg_bs, w_branch_a, w_branch_b, w_out):
    B, T, _ = x.shape
    zq, zf, zi, zg, zu, zv, za, zb = jnp.split(x @ w_in, IN_SPLITS, axis=-1)

    f32 = jnp.float32
    lbf = lb.astype(f32)
    zff = zf.astype(f32)
    f = lbf + (1.0 - lbf) * jax.nn.sigmoid(zff)
    log_f = jnp.log(f)
    k = (1.0 - lbf) * jax.nn.sigmoid(-zff)
    hs = lambda a, d: a.reshape(B, T, HG_HEADS, d)
    o = hgrn2_chunkwise(hs(zq.astype(f32), HG_DK), hs(k, HG_DK),
                        hs(zi.astype(f32), HG_DV), hs(log_f, HG_DK))
    o = o * lax.rsqrt(jnp.mean(jnp.square(o), axis=-1, keepdims=True) + RMS_EPS)
    o = o * hg_norm_g.astype(f32).reshape(HG_HEADS, HG_DV)
    o = o.reshape(B, T, HG_V).astype(x.dtype) * jax.nn.silu(zg)
    y_a = o @ w_branch_a

    u = jax.nn.gelu(zu)
    v = layer_norm(jax.nn.gelu(zv), sg_ln_g, sg_ln_b)
    n_chunks = T // SG_CHUNK
    v = v.reshape(B, n_chunks, SG_CHUNK, SG_GROUPS, SG_GROUP_DIM)
    ws = sg_ws * jnp.tril(jnp.ones((SG_CHUNK, SG_CHUNK), sg_ws.dtype))
    mixed = jnp.einsum('gts,bnsgc->bntgc', ws, v) + sg_bs.T[None, None, :, :, None]
    y_b = (u * mixed.reshape(B, T, SG_WIDTH)) @ w_branch_b

    y = jax.nn.sigmoid(za) * y_a + jax.nn.sigmoid(zb) * y_b
    return y @ w_out


def setup_inputs(seed: int = 0) -> dict:
    key = jax.random.key(seed)
    ks = jax.random.split(key, 20)
    n = jax.random.normal
    f32 = jnp.float32
    return {
        "x": n(ks[0], (BATCH, SEQ, D_MODEL), f32),
        "ffn1_w13": n(ks[1], (DEPTH, D_MODEL, 2 * D_FF), f32) * D_MODEL ** -0.5,
        "ffn1_w2": n(ks[2], (DEPTH, D_FF, D_MODEL), f32) * (D_FF ** -0.5 * BETA),
        "ffn2_w13": n(ks[3], (DEPTH, D_MODEL, 2 * D_FF), f32) * D_MODEL ** -0.5,
        "ffn2_w2": n(ks[4], (DEPTH, D_FF, D_MODEL), f32) * (D_FF ** -0.5 * BETA),
        "ln_g": 1.0 + 0.02 * n(ks[5], (DEPTH, 3, D_MODEL), f32),
        "ln_b": 0.02 * n(ks[6], (DEPTH, 3, D_MODEL), f32),
        "w_in": n(ks[7], (DEPTH, D_MODEL, D_IN), f32) * D_MODEL ** -0.5,
        "hg_lb": 0.5 * n(ks[8], (DEPTH, HG_K), f32),
        "hg_norm_g": 1.0 + 0.02 * n(ks[9], (DEPTH, HG_V), f32),
        "sg_ln_g": 1.0 + 0.02 * n(ks[10], (DEPTH, SG_WIDTH), f32),
        "sg_ln_b": 0.02 * n(ks[11], (DEPTH, SG_WIDTH), f32),
        "sg_ws": n(ks[12], (DEPTH, SG_GROUPS, SG_CHUNK, SG_CHUNK), f32) * SG_CHUNK ** -0.5,
        "sg_bs": 1.0 + 0.1 * n(ks[13], (DEPTH, SG_GROUPS, SG_CHUNK), f32),
        "w_branch_a": n(ks[14], (DEPTH, HG_V, D_MODEL), f32) * (HG_V ** -0.5 * BETA),
        "w_branch_b": n(ks[15], (DEPTH, SG_WIDTH, D_MODEL), f32) * (SG_WIDTH ** -0.5 * BETA),
        "w_out": n(ks[16], (DEPTH, D_MODEL, D_MODEL), f32) * (D_MODEL ** -0.5 * BETA),
    }


def reference(x, ffn1_w13, ffn1_w2, ffn2_w13, ffn2_w2, ln_g, ln_b, w_in, hg_lb, hg_norm_g,
              sg_ln_g, sg_ln_b, sg_ws, sg_bs, w_branch_a, w_branch_b, w_out):
    lb_soft = jax.nn.softmax(hg_lb.astype(jnp.float32), axis=0)
    lower_bounds = jnp.cumsum(lb_soft, axis=0) - lb_soft[0]
    for l in range(DEPTH):
        x = layer_norm(ALPHA * x + 0.5 * swiglu(x, ffn1_w13[l], ffn1_w2[l]), ln_g[l, 0], ln_b[l, 0])
        m = mixer(x, w_in[l], lower_bounds[l], hg_norm_g[l], sg_ln_g[l], sg_ln_b[l], sg_ws[l],
                  sg_bs[l], w_branch_a[l], w_branch_b[l], w_out[l])
        x = layer_norm(ALPHA * x + m, ln_g[l, 1], ln_b[l, 1])
        x = layer_norm(ALPHA * x + 0.5 * swiglu(x, ffn2_w13[l], ffn2_w2[l]), ln_g[l, 2], ln_b[l, 2])
    return x
```

```cpp
#include <hip/hip_runtime.h>
#include <cstdio>
#include <cstdint>
namespace pg8 {
#define PG8_LAS __attribute__((address_space(3)))
typedef unsigned short bf16_t;
typedef short bf16x8 __attribute__((ext_vector_type(8)));
typedef float f32x4 __attribute__((ext_vector_type(4)));
typedef unsigned u32x4 __attribute__((ext_vector_type(4)));
constexpr int BM = 256, BK = 64, HALF = 128, HTB = HALF * BK * 2  , STAGE_BYTES = 8 * HTB, NXCD = 8, WGM = 8;

__host__ __device__ __forceinline__ int lds_byte(int r, int c) { const int st = (r >> 4) * 2 + (c >> 5), rr = r & 15, cc = c & 31, ob = rr * 64 + cc * 2; return st * 1024 + (ob ^ (((ob >> 9) & 1) << 5)); }
__host__ __device__ __forceinline__ void stage_rc(int b, int& R, int& C) { const int st = b / 1024, sb = b % 1024, swz = sb ^ (((sb >> 9) & 1) << 5); R = (st >> 1) * 16 + swz / 64; C = (st & 1) * 32 + (swz % 64) / 2; }
__host__ __device__ __forceinline__ int perm32(int rho) { const int n = rho >> 4, i = rho & 15; return 8 * (i >> 2) + 4 * n + (i & 3); }

struct Unit { int pm, pn; };
struct Gemm { const bf16_t* A; const bf16_t* Bt; int M, N, K; };

struct StaticOrder {
    int nM, nN, nwg, G, c;
    __host__ __device__ void init(int M, int N, int G_, int c_) { nM = M / BM; nN = N / BM; nwg = nM * nN; G = G_; c = c_; }
    __host__ __device__ bool next(int i, Unit& u) const {
        const long L = (long)i * G + c; if (L >= nwg) return false;
        int wgid = (int)L; { const int q = nwg / NXCD, r = nwg % NXCD, xcd = wgid % NXCD, off = wgid / NXCD; wgid = (xcd < r ? xcd * (q + 1) : r * (q + 1) + (xcd - r) * q) + off; }
        const int nig = WGM * nN, gid = wgid / nig, fm = gid * WGM, gsz = (nM - fm) < WGM ? (nM - fm) : WGM;
        u.pm = fm + ((wgid % nig) % gsz); u.pn = (wgid % nig) / gsz; return true;
    }
    __device__ __forceinline__ void a_ready(const Unit&) const {}
    __device__ __forceinline__ void done(const Unit&) const {}
};

__device__ __forceinline__ unsigned cvt_pk_bf16(float lo, float hi) { unsigned r; asm volatile("s_nop 0\n\tv_cvt_pk_bf16_f32 %0, %1, %2" : "=v"(r) : "v"(lo), "v"(hi)); return r; }
typedef float f32x2 __attribute__((ext_vector_type(2)));
__device__ __forceinline__ f32x2 gelu_pk(f32x2 v) {
    const f32x2 av = __builtin_elementwise_abs(v), d = av * 0.2316418882f + 1.0f;
    f32x2 t; t.x = __builtin_amdgcn_rcpf(d.x); t.y = __builtin_amdgcn_rcpf(d.y);
    f32x2 q = t * 0.5307027145f + (-0.7265760135f); q = q * t + 0.7107068705f; q = q * t + (-0.142248368f); q = q * t + 0.127414796f; q = q * t;
    const f32x2 s = (v * v) * (-0.72134752044f);
    f32x2 e; e.x = __builtin_amdgcn_exp2f(s.x); e.y = __builtin_amdgcn_exp2f(s.y);
    const f32x2 m = v * (q * e), r = v - m;
    f32x2 o; o.x = v.x < 0.f ? m.x : r.x; o.y = v.y < 0.f ? m.y : r.y; return o;
}

template <class Epi, class Sched, bool ALIGN_EPI = false, bool SP2 = false>
__device__ __forceinline__ void gemm_phase(PG8_LAS unsigned char* lds, const Gemm g, const Sched& S, const Epi& E, int tid_in) {
    const int tid = tid_in, wid = __builtin_amdgcn_readfirstlane(tid >> 6), lane = tid & 63, wr = wid >> 2, wc = wid & 3, fr = lane & 15, fq = lane >> 4;
    const int K = g.K, nt = K / BK;
    unsigned voffA[2], voffB[2];
#pragma unroll
    for (int i = 0; i < 2; ++i) { int R, C; stage_rc(tid * 16 + i * 8192, R, C); const int Rb = Epi::PERM ? ((R & ~31) + perm32(R & 31)) : R;
        voffA[i] = (unsigned)(R * K + C) * 2u; voffB[i] = (unsigned)(Rb * K + C) * 2u; }
    const size_t kstep = (size_t)(BK * 2);
    const size_t hstep = (size_t)HALF * K * 2;
    const size_t tstep = 2 * hstep;
    const unsigned ldsw = (unsigned)wid * 1024u;
    const int aoff = lds_byte(wr * 64 + fr, fq * 8), boff = lds_byte(wc * 32 + fr, fq * 8);
#define PG8_SA(b, h) (((b) * 2 + (h)) * HTB)
#define PG8_SB(b, h) ((4 + (b) * 2 + (h)) * HTB)
#define PG8_STAGE(bufoff, gbase, voff) do { _Pragma("unroll") for (int _i = 0; _i < 2; ++_i) \
        __builtin_amdgcn_global_load_lds((const unsigned*)((const char*)(gbase) + (voff)[_i]), (PG8_LAS unsigned*)(lds + (bufoff) + ldsw + _i * 8192), 16, 0, 0); } while (0)
#define PG8_LDA(dst, b, h) do { _Pragma("unroll") for (int m = 0; m < 4; ++m) _Pragma("unroll") for (int k = 0; k < 2; ++k) dst[m][k] = *(const PG8_LAS bf16x8*)(lds + PG8_SA(b, h) + aoff + m * 2048 + k * 1024); } while (0)
#define PG8_LDB(dst, b, h) do { _Pragma("unroll") for (int n = 0; n < 2; ++n) _Pragma("unroll") for (int k = 0; k < 2; ++k) dst[n][k] = *(const PG8_LAS bf16x8*)(lds + PG8_SB(b, h) + boff + n * 2048 + k * 1024); } while (0)
#define PG8_MMA(ai, bj, At, Bt) do { __builtin_amdgcn_s_setprio(1); _Pragma("unroll") for (int m = 0; m < 4; ++m) _Pragma("unroll") for (int n = 0; n < 2; ++n) _Pragma("unroll") for (int k = 0; k < 2; ++k) \
        acc[ai][bj][m][n] = __builtin_amdgcn_mfma_f32_16x16x32_bf16(Bt[n][k], At[m][k], acc[ai][bj][m][n], 0, 0, 0); __builtin_amdgcn_s_setprio(0); } while (0)
#define PG8_WAIT_V(n) asm volatile("s_waitcnt vmcnt(" #n ")" ::: "memory")
#define PG8_WAIT_L(n) asm volatile("s_waitcnt lgkmcnt(" #n ")" ::: "memory")
#define PG8_BAR __builtin_amdgcn_s_barrier()
#define PG8_SCHED __builtin_amdgcn_sched_barrier(0)
    Unit cur, nxt; int ui = 0;
    if (!S.next(0, cur)) return;
    f32x4 acc[2][2][4][2];
#pragma unroll
    for (int a = 0; a < 2; ++a)
#pragma unroll
        for (int b = 0; b < 2; ++b)
#pragma unroll
            for (int m = 0; m < 4; ++m)
#pragma unroll
                for (int n = 0; n < 2; ++n) acc[a][b][m][n] = (f32x4){0.f, 0.f, 0.f, 0.f};
    bf16x8 At[4][2], B0[2][2], B1[2][2];
    const char* cA = (const char*)g.A + (size_t)cur.pm * tstep; const char* cB = (const char*)g.Bt + (size_t)cur.pn * tstep;
    S.a_ready(cur);
    if constexpr (SP2) {
        PG8_STAGE(PG8_SB(0, 0), cB, voffB); PG8_STAGE(PG8_SB(0, 1), cB + hstep, voffB); PG8_STAGE(PG8_SA(0, 0), cA, voffA); PG8_STAGE(PG8_SA(0, 1), cA + hstep, voffA);
        if (wr == 1) PG8_BAR;
        PG8_WAIT_V(2); PG8_BAR;
        PG8_STAGE(PG8_SB(1, 0), cB + kstep, voffB); PG8_STAGE(PG8_SA(1, 0), cA + kstep, voffA); PG8_STAGE(PG8_SB(1, 1), cB + hstep + kstep, voffB);
        PG8_WAIT_V(6); PG8_BAR;
    } else {
        PG8_STAGE(PG8_SB(0, 0), cB, voffB); PG8_STAGE(PG8_SA(0, 0), cA, voffA); PG8_STAGE(PG8_SB(0, 1), cB + hstep, voffB); PG8_STAGE(PG8_SA(0, 1), cA + hstep, voffA);
        if (wr == 1) PG8_BAR;
        PG8_WAIT_V(4); PG8_BAR;
        PG8_STAGE(PG8_SB(1, 0), cB + kstep, voffB); PG8_STAGE(PG8_SA(1, 0), cA + kstep, voffA); PG8_STAGE(PG8_SB(1, 1), cB + hstep + kstep, voffB);
        PG8_WAIT_V(6); PG8_BAR;
    }
    for (;;) {
        const bool has_next = S.next(ui + 1, nxt);
        const char* nA = has_next ? (const char*)g.A + (size_t)nxt.pm * tstep : cA; const char* nB = has_next ? (const char*)g.Bt + (size_t)nxt.pn * tstep : cB;
        for (int t = 0; t < nt; t += 2) {
            const bool last = (t == nt - 2);
            const char* a1 = cA + (size_t)(t + 1) * kstep;
            const char* a2 = last ? nA : cA + (size_t)(t + 2) * kstep; const char* b2 = last ? nB : cB + (size_t)(t + 2) * kstep;
            const char* a3 = a2 + kstep; const char* b3 = b2 + kstep;
            if (last && has_next) S.a_ready(nxt);
            if constexpr (SP2) {
            PG8_LDB(B0, 0, 0); PG8_LDB(B1, 0, 1); PG8_SCHED; PG8_LDA(At, 0, 0); PG8_STAGE(PG8_SA(1, 1), a1 + hstep, voffA);
            PG8_WAIT_V(8); PG8_WAIT_L(0); PG8_BAR; PG8_MMA(0, 0, At, B0); PG8_MMA(0, 1, At, B1); PG8_BAR; PG8_SCHED;
            PG8_LDA(At, 0, 1); PG8_STAGE(PG8_SB(0, 0), b2, voffB); PG8_STAGE(PG8_SB(0, 1), b2 + hstep, voffB); PG8_STAGE(PG8_SA(0, 0), a2, voffA);
            PG8_WAIT_V(8); PG8_WAIT_L(0); PG8_BAR; PG8_MMA(1, 0, At, B0); PG8_MMA(1, 1, At, B1); PG8_BAR; PG8_SCHED;
            PG8_LDB(B0, 1, 0); PG8_LDB(B1, 1, 1); PG8_SCHED; PG8_LDA(At, 1, 0); PG8_STAGE(PG8_SA(0, 1), a2 + hstep, voffA);
            PG8_WAIT_V(8); PG8_WAIT_L(0); PG8_BAR; PG8_MMA(0, 0, At, B0); PG8_MMA(0, 1, At, B1); PG8_BAR; PG8_SCHED;
            PG8_LDA(At, 1, 1); PG8_STAGE(PG8_SB(1, 0), b3, voffB); PG8_STAGE(PG8_SB(1, 1), b3 + hstep, voffB); PG8_STAGE(PG8_SA(1, 0), a3, voffA);
            PG8_WAIT_V(8); PG8_WAIT_L(0); PG8_BAR; PG8_MMA(1, 0, At, B0); PG8_MMA(1, 1, At, B1); PG8_BAR; PG8_SCHED;
            } else {
            PG8_LDB(B0, 0, 0); PG8_SCHED; PG8_LDA(At, 0, 0); PG8_STAGE(PG8_SA(1, 1), a1 + hstep, voffA);
            PG8_WAIT_L(8); PG8_BAR; PG8_WAIT_L(0); PG8_MMA(0, 0, At, B0); PG8_BAR; PG8_SCHED;
            PG8_LDB(B1, 0, 1); PG8_STAGE(PG8_SB(0, 0), b2, voffB);
            PG8_BAR; PG8_WAIT_L(0); PG8_MMA(0, 1, At, B1); PG8_BAR;
            PG8_LDA(At, 0, 1); PG8_STAGE(PG8_SA(0, 0), a2, voffA);
            PG8_BAR; PG8_WAIT_L(0); PG8_MMA(1, 0, At, B0); PG8_BAR; PG8_SCHED;
            PG8_STAGE(PG8_SB(0, 1), b2 + hstep, voffB);
            PG8_WAIT_V(6); PG8_BAR; PG8_MMA(1, 1, At, B1); PG8_BAR;
            PG8_LDB(B0, 1, 0); PG8_SCHED; PG8_LDA(At, 1, 0); PG8_STAGE(PG8_SA(0, 1), a2 + hstep, voffA);
            PG8_WAIT_L(8); PG8_BAR; PG8_WAIT_L(0); PG8_MMA(0, 0, At, B0); PG8_BAR; PG8_SCHED;
            PG8_LDB(B1, 1, 1); PG8_STAGE(PG8_SB(1, 0), b3, voffB);
            PG8_BAR; PG8_WAIT_L(0); PG8_MMA(0, 1, At, B1); PG8_BAR;
            PG8_LDA(At, 1, 1); PG8_STAGE(PG8_SA(1, 0), a3, voffA);
            PG8_BAR; PG8_WAIT_L(0); PG8_MMA(1, 0, At, B0); PG8_BAR; PG8_SCHED;
            PG8_STAGE(PG8_SB(1, 1), b3 + hstep, voffB);
            PG8_WAIT_V(6); PG8_BAR; PG8_MMA(1, 1, At, B1); PG8_BAR;
            }
        }
        if constexpr (ALIGN_EPI) { if (wr == 0) PG8_BAR; }
        if constexpr (!Epi::AFTER_DRAIN) { E(acc, cur, wr, wc, fr, fq); S.done(cur); }
        if (!has_next) break;
#pragma unroll
        for (int a = 0; a < 2; ++a)
#pragma unroll
            for (int b = 0; b < 2; ++b)
#pragma unroll
                for (int m = 0; m < 4; ++m)
#pragma unroll
                    for (int n = 0; n < 2; ++n) acc[a][b][m][n] = (f32x4){0.f, 0.f, 0.f, 0.f};
        cur = nxt; cA = nA; cB = nB; ++ui;
        if constexpr (ALIGN_EPI) { if (wr == 1) PG8_BAR; }
    }
    PG8_WAIT_V(0);
    if constexpr (!ALIGN_EPI) { if (wr == 0) PG8_BAR; }
    PG8_BAR;
    if constexpr (Epi::AFTER_DRAIN) { E.fused(acc, cur, wr, wc, fr, fq, lds, wid, lane); S.done(cur); }
#undef PG8_SA
#undef PG8_SB
#undef PG8_STAGE
#undef PG8_LDA
#undef PG8_LDB
#undef PG8_MMA
#undef PG8_WAIT_V
#undef PG8_WAIT_L
#undef PG8_BAR
#undef PG8_SCHED
}
}
namespace pg8 {
typedef unsigned u32x2 __attribute__((ext_vector_type(2)));
__device__ __forceinline__ float fsigmoid(float x) { return __builtin_amdgcn_rcpf(1.0f + __expf(-x)); }
__device__ __forceinline__ float fsilu(float x) { return x * fsigmoid(x); }
__device__ __forceinline__ float fgelu_tanh(float x) { const float u = 1.5957691216057308f * (x + 0.044715f * x * x * x); return x * fsigmoid(u); }
__device__ __forceinline__ float bf2f(unsigned short h) { return __uint_as_float(((unsigned)h) << 16); }
__device__ __forceinline__ float bflo(unsigned w) { return __uint_as_float(w << 16); }
__device__ __forceinline__ float bfhi(unsigned w) { return __uint_as_float(w & 0xffff0000u); }

template <class F> __device__ __forceinline__ void epi_bf16(const f32x4 (&acc)[2][2][4][2], bf16_t* base, int ld, int row0, int col0, F f) {
#pragma unroll
    for (int ai = 0; ai < 2; ++ai)
#pragma unroll
        for (int m = 0; m < 4; ++m) { bf16_t* rowp = base + (size_t)(row0 + ai * HALF + m * 16) * ld + col0;
#pragma unroll
            for (int bj = 0; bj < 2; ++bj) { const f32x4 v0 = acc[ai][bj][m][0], v1 = acc[ai][bj][m][1];
                u32x4 w; w.x = cvt_pk_bf16(f(v0[0]), f(v0[1])); w.y = cvt_pk_bf16(f(v0[2]), f(v0[3])); w.z = cvt_pk_bf16(f(v1[0]), f(v1[1])); w.w = cvt_pk_bf16(f(v1[2]), f(v1[3]));
                *(u32x4*)(rowp + bj * HALF) = w; } }
}

struct EpiSwiGLU {
    static constexpr bool PERM = true, AFTER_DRAIN = false;
    bf16_t* H; int ldh;
    __device__ __forceinline__ void operator()(const f32x4 (&acc)[2][2][4][2], const Unit& u, int wr, int wc, int fr, int fq) const {
        const int row0 = u.pm * BM + wr * 64 + fr, col0 = u.pn * HALF + wc * 32 + 8 * fq;
#pragma unroll
        for (int ai = 0; ai < 2; ++ai)
#pragma unroll
            for (int m = 0; m < 4; ++m) { bf16_t* rowp = H + (size_t)(row0 + ai * HALF + m * 16) * ldh + col0;
                const f32x4 a0 = acc[ai][0][m][0], a1 = acc[ai][0][m][1], b0 = acc[ai][1][m][0], b1 = acc[ai][1][m][1];
                u32x4 w; w.x = cvt_pk_bf16(fsilu(a0[0]) * b0[0], fsilu(a0[1]) * b0[1]); w.y = cvt_pk_bf16(fsilu(a0[2]) * b0[2], fsilu(a0[3]) * b0[3]);
                w.z = cvt_pk_bf16(fsilu(a1[0]) * b1[0], fsilu(a1[1]) * b1[1]); w.w = cvt_pk_bf16(fsilu(a1[2]) * b1[2], fsilu(a1[3]) * b1[3]);
                *(u32x4*)rowp = w; }
    }
};

struct EpiResid {
    static constexpr bool PERM = true, AFTER_DRAIN = false;
    const float* X; float* Z; float alpha, s;
    __device__ __forceinline__ void operator()(const f32x4 (&acc)[2][2][4][2], const Unit& u, int wr, int wc, int fr, int fq) const {
        const int row0 = u.pm * BM + wr * 64 + fr, col0 = u.pn * BM + wc * 32 + 8 * fq;
#pragma unroll
        for (int ai = 0; ai < 2; ++ai)
#pragma unroll
            for (int m = 0; m < 4; ++m) { const size_t off = (size_t)(row0 + ai * HALF + m * 16) * 1024 + col0;
#pragma unroll
                for (int bj = 0; bj < 2; ++bj)
#pragma unroll
                    for (int n = 0; n < 2; ++n) { const f32x4 xv = *(const f32x4*)(X + off + bj * HALF + 4 * n); *(f32x4*)(Z + off + bj * HALF + 4 * n) = xv * alpha + acc[ai][bj][m][n] * s; } }
    }
};

struct EpiInProj {
    static constexpr bool PERM = true, AFTER_DRAIN = false;
    bf16_t *Q, *KB, *I, *G, *U, *V, *GA, *GB; float* LF; const float* LB;
    __device__ __forceinline__ void operator()(const f32x4 (&acc)[2][2][4][2], const Unit& u, int wr, int wc, int fr, int fq) const {
        const int row0 = u.pm * BM + wr * 64 + fr, cw = wc * 32 + 8 * fq, pn = u.pn;
        if (pn < 2) epi_bf16(acc, Q, 512, row0, pn * 256 + cw, [](float v) { return v; });
        else if (pn < 4) {
            const int c0 = (pn - 2) * 256 + cw;
#pragma unroll
            for (int bj = 0; bj < 2; ++bj) {
                const f32x4 l0 = *(const f32x4*)(LB + c0 + bj * HALF), l1 = *(const f32x4*)(LB + c0 + bj * HALF + 4);
#pragma unroll
                for (int ai = 0; ai < 2; ++ai)
#pragma unroll
                    for (int m = 0; m < 4; ++m) { const size_t off = (size_t)(row0 + ai * HALF + m * 16) * 512 + c0 + bj * HALF;
                        const f32x4 v0 = acc[ai][bj][m][0], v1 = acc[ai][bj][m][1]; f32x4 f0, f1, k0, k1;
#pragma unroll
                        for (int i = 0; i < 4; ++i) { const float e0 = __expf(-v0[i]), r0 = __builtin_amdgcn_rcpf(1.0f + e0), e1 = __expf(-v1[i]), r1 = __builtin_amdgcn_rcpf(1.0f + e1);
                            f0[i] = __logf(l0[i] + (1.0f - l0[i]) * r0); k0[i] = (1.0f - l0[i]) * (e0 * r0);
                            f1[i] = __logf(l1[i] + (1.0f - l1[i]) * r1); k1[i] = (1.0f - l1[i]) * (e1 * r1); }
                        *(f32x4*)(LF + off) = f0; *(f32x4*)(LF + off + 4) = f1;
                        u32x4 w; w.x = cvt_pk_bf16(k0[0], k0[1]); w.y = cvt_pk_bf16(k0[2], k0[3]); w.z = cvt_pk_bf16(k1[0], k1[1]); w.w = cvt_pk_bf16(k1[2], k1[3]);
                        *(u32x4*)(KB + off) = w; } }
        }
        else if (pn < 6) epi_bf16(acc, I, 512, row0, (pn - 4) * 256 + cw, [](float v) { return v; });
        else if (pn < 8) epi_bf16(acc, G, 512, row0, (pn - 6) * 256 + cw, [](float v) { return fsilu(v); });
        else if (pn < 10) epi_bf16(acc, U, 512, row0, (pn - 8) * 256 + cw, [](float v) { return fgelu_tanh(v); });
        else if (pn < 12) epi_bf16(acc, V, 512, row0, (pn - 10) * 256 + cw, [](float v) { return fgelu_tanh(v); });
        else if (pn < 16) epi_bf16(acc, GA, 1024, row0, (pn - 12) * 256 + cw, [](float v) { return fsigmoid(v); });
        else epi_bf16(acc, GB, 1024, row0, (pn - 16) * 256 + cw, [](float v) { return fsigmoid(v); });
    }
};

struct EpiBranchA {
    static constexpr bool PERM = true, AFTER_DRAIN = false;
    const bf16_t* GA; float* YP;
    __device__ __forceinline__ void operator()(const f32x4 (&acc)[2][2][4][2], const Unit& u, int wr, int wc, int fr, int fq) const {
        const int row0 = u.pm * BM + wr * 64 + fr, col0 = u.pn * BM + wc * 32 + 8 * fq;
#pragma unroll
        for (int ai = 0; ai < 2; ++ai)
#pragma unroll
            for (int m = 0; m < 4; ++m) { const size_t off = (size_t)(row0 + ai * HALF + m * 16) * 1024 + col0;
#pragma unroll
                for (int bj = 0; bj < 2; ++bj) { const u32x4 g = *(const u32x4*)(GA + off + bj * HALF); const f32x4 v0 = acc[ai][bj][m][0], v1 = acc[ai][bj][m][1];
                    f32x4 o0, o1; o0[0] = bflo(g.x) * v0[0]; o0[1] = bfhi(g.x) * v0[1]; o0[2] = bflo(g.y) * v0[2]; o0[3] = bfhi(g.y) * v0[3];
                    o1[0] = bflo(g.z) * v1[0]; o1[1] = bfhi(g.z) * v1[1]; o1[2] = bflo(g.w) * v1[2]; o1[3] = bfhi(g.w) * v1[3];
                    *(f32x4*)(YP + off + bj * HALF) = o0; *(f32x4*)(YP + off + bj * HALF + 4) = o1; } }
    }
};
struct EpiBranchB {
    static constexpr bool PERM = true, AFTER_DRAIN = false;
    bf16_t* GBY; const float* YP;
    __device__ __forceinline__ void operator()(const f32x4 (&acc)[2][2][4][2], const Unit& u, int wr, int wc, int fr, int fq) const {
        const int row0 = u.pm * BM + wr * 64 + fr, col0 = u.pn * BM + wc * 32 + 8 * fq;
#pragma unroll
        for (int ai = 0; ai < 2; ++ai)
#pragma unroll
            for (int m = 0; m < 4; ++m) { const size_t off = (size_t)(row0 + ai * HALF + m * 16) * 1024 + col0;
#pragma unroll
                for (int bj = 0; bj < 2; ++bj) { const u32x4 g = *(const u32x4*)(GBY + off + bj * HALF); const f32x4 v0 = acc[ai][bj][m][0], v1 = acc[ai][bj][m][1];
                    const f32x4 p0 = *(const f32x4*)(YP + off + bj * HALF), p1 = *(const f32x4*)(YP + off + bj * HALF + 4);
                    u32x4 w; w.x = cvt_pk_bf16(p0[0] + bflo(g.x) * v0[0], p0[1] + bfhi(g.x) * v0[1]); w.y = cvt_pk_bf16(p0[2] + bflo(g.y) * v0[2], p0[3] + bfhi(g.y) * v0[3]);
                    w.z = cvt_pk_bf16(p1[0] + bflo(g.z) * v1[0], p1[1] + bfhi(g.z) * v1[1]); w.w = cvt_pk_bf16(p1[2] + bflo(g.w) * v1[2], p1[3] + bfhi(g.w) * v1[3]);
                    *(u32x4*)(GBY + off + bj * HALF) = w; } }
    }
};
}
#include <hip/hip_cooperative_groups.h>
namespace cg = cooperative_groups;
#define LAS __attribute__((address_space(3)))
typedef unsigned short bf16;
typedef unsigned v4u __attribute__((ext_vector_type(4)));
typedef unsigned v2u __attribute__((ext_vector_type(2)));
typedef float f32x4 __attribute__((ext_vector_type(4)));
typedef short bf16x8 __attribute__((ext_vector_type(8)));

constexpr int NWAVES = 8, NTHR = 512;
constexpr int DM = 1024, BATCH = 8, SEQ = 2048, DEPTH = 4, M = BATCH * SEQ, DFF = 2816, DIN = 5120;
constexpr float ALPHA = 1.681792830507429f;
constexpr size_t MiB = 1u << 20;
constexpr size_t WS_LB = 4096;
constexpr size_t WS_W13A = 2 * MiB, WS_W2A = 13 * MiB, WS_W13B = 19 * MiB, WS_W2B = 30 * MiB, WS_WIN = 36 * MiB, WS_WA = 46 * MiB, WS_WB = 47 * MiB, WS_WOUT = 48 * MiB;
constexpr size_t WS_XB = 50 * MiB;
constexpr size_t WS_BIG = 82 * MiB;
constexpr size_t WS_H = WS_BIG;
constexpr size_t WS_Q = WS_BIG, WS_KB = WS_BIG + 16 * MiB, WS_LF = WS_BIG + 32 * MiB, WS_I = WS_BIG + 64 * MiB, WS_G = WS_BIG + 80 * MiB, WS_U = WS_BIG + 96 * MiB,
                 WS_V = WS_BIG + 112 * MiB, WS_GA = WS_BIG + 128 * MiB, WS_GB = WS_BIG + 160 * MiB, WS_QD = WS_BIG + 192 * MiB, WS_DS = WS_BIG + 208 * MiB, WS_DEC = WS_BIG + 272 * MiB;
constexpr size_t WS_Z = WS_DS;
constexpr size_t WS_END = WS_BIG + 273 * MiB;
constexpr int LDS_BYTES = 147456;

__device__ __forceinline__ unsigned f2bf(float f) { unsigned u = __builtin_bit_cast(unsigned, f); return (u + 0x7fffu + ((u >> 16) & 1u)) >> 16; }
__device__ __forceinline__ unsigned pk2(float lo, float hi) { return f2bf(lo) | (f2bf(hi) << 16); }
__device__ __forceinline__ float bf2f(unsigned h) { return __uint_as_float(h << 16); }
__device__ __forceinline__ float wave_sum(float v) {
#pragma unroll
    for (int o = 1; o < 64; o <<= 1) v += __shfl_xor(v, o);
    return v;
}
#define LDS_WAIT() asm volatile("s_waitcnt lgkmcnt(0)" ::: "memory")

__device__ __forceinline__ void transpose_item(const float* W, int K, int N, bf16* WT, int mode, LAS float* scr, int item, int lane) {
    const int nblk = N / 32, kb = item / nblk, nb = item % nblk, k0 = 64 * kb, n0 = 32 * nb;
    int drow = n0;
    if (mode == 1) { int c = n0; if (c < DFF) drow = (c / 128) * 256 + (c % 128); else { c -= DFF; drow = (c / 128) * 256 + 128 + (c % 128); } }
#pragma unroll 8
    for (int i = 0; i < 32; ++i) { const int kk = 2 * i + (lane >> 5); scr[kk * 33 + (lane & 31)] = W[(size_t)(k0 + kk) * N + n0 + (lane & 31)]; }
    LDS_WAIT(); asm volatile("" ::: "memory");
    const int c = lane & 7;
#pragma unroll
    for (int j = 0; j < 4; ++j) { const int n = (lane >> 3) + 8 * j; const LAS float* s = scr + (8 * c) * 33 + n;
        v4u o; o.x = pk2(s[0 * 33], s[1 * 33]); o.y = pk2(s[2 * 33], s[3 * 33]); o.z = pk2(s[4 * 33], s[5 * 33]); o.w = pk2(s[6 * 33], s[7 * 33]);
        *(v4u*)(WT + (size_t)(drow + n) * K + k0 + 8 * c) = o; }
    LDS_WAIT(); asm volatile("" ::: "memory");
}

struct P {
    const float *x, *ffn1_w13, *ffn1_w2, *ffn2_w13, *ffn2_w2, *ln_g, *ln_b, *w_in, *hg_lb, *hg_norm_g, *sg_ln_g, *sg_ln_b, *sg_ws, *sg_bs, *w_a, *w_b, *w_out;
    float* out; unsigned char* ws; int ph_lo, ph_hi;
};

__device__ __forceinline__ void phase_weights(const P& p, int l, LAS unsigned char* lds, int gw, int NGW, int wave, int lane) {
    LAS float* scr = (LAS float*)(lds + wave * 16384);
    constexpr int I13 = (DM / 64) * (2 * DFF / 32), I2 = (DFF / 64) * (DM / 32), IIN = (DM / 64) * (DIN / 32), IAB = (512 / 64) * (DM / 32), IOUT = (DM / 64) * (DM / 32);
    constexpr int NITEMS = 2 * I13 + 2 * I2 + IIN + 2 * IAB + IOUT;
    unsigned char* ws = p.ws;
    for (int it = gw; it < NITEMS; it += NGW) {
        int r = it;
        if (r < I13) { transpose_item(p.ffn1_w13 + (size_t)l * DM * 2 * DFF, DM, 2 * DFF, (bf16*)(ws + WS_W13A), 1, scr, r, lane); continue; } r -= I13;
        if (r < I13) { transpose_item(p.ffn2_w13 + (size_t)l * DM * 2 * DFF, DM, 2 * DFF, (bf16*)(ws + WS_W13B), 1, scr, r, lane); continue; } r -= I13;
        if (r < I2) { transpose_item(p.ffn1_w2 + (size_t)l * DFF * DM, DFF, DM, (bf16*)(ws + WS_W2A), 0, scr, r, lane); continue; } r -= I2;
        if (r < I2) { transpose_item(p.ffn2_w2 + (size_t)l * DFF * DM, DFF, DM, (bf16*)(ws + WS_W2B), 0, scr, r, lane); continue; } r -= I2;
        if (r < IIN) { transpose_item(p.w_in + (size_t)l * DM * DIN, DM, DIN, (bf16*)(ws + WS_WIN), 0, scr, r, lane); continue; } r -= IIN;
        if (r < IAB) { transpose_item(p.w_a + (size_t)l * 512 * DM, 512, DM, (bf16*)(ws + WS_WA), 0, scr, r, lane); continue; } r -= IAB;
        if (r < IAB) { transpose_item(p.w_b + (size_t)l * 512 * DM, 512, DM, (bf16*)(ws + WS_WB), 0, scr, r, lane); continue; } r -= IAB;
        transpose_item(p.w_out + (size_t)l * DM * DM, DM, DM, (bf16*)(ws + WS_WOUT), 0, scr, r, lane);
    }
}

__device__ __forceinline__ void phase_x0(const P& p, int gw, int NGW, int lane, int tid, int bid) {
    bf16* XB = (bf16*)(p.ws + WS_XB);
    for (int m = gw; m < M; m += NGW) {
        const f32x4* xr = (const f32x4*)(p.x + (size_t)m * DM) + lane; unsigned long long* o8 = (unsigned long long*)(XB + (size_t)m * DM) + lane;
#pragma unroll
        for (int j = 0; j < 4; ++j) { const f32x4 v = xr[64 * j]; o8[64 * j] = (unsigned long long)pk2(v.x, v.y) | ((unsigned long long)pk2(v.z, v.w) << 32); }
    }
    if (bid == 0) {
        float* LB = (float*)(p.ws + WS_LB); const int c = tid;
        float v[4], mx = -1e30f; for (int l = 0; l < 4; ++l) { v[l] = p.hg_lb[l * 512 + c]; mx = fmaxf(mx, v[l]); }
        float s = 0.f; for (int l = 0; l < 4; ++l) { v[l] = expf(v[l] - mx); s += v[l]; }
        float cum = 0.f; const float s0 = v[0] / s;
        for (int l = 0; l < 4; ++l) { cum += v[l] / s; LB[l * 512 + c] = cum - s0; }
    }
}

__device__ __forceinline__ void phase_ln(const float* Z, const float* g, const float* b, float* X, bf16* XB, int gw, int NGW, int lane) {
    f32x4 gv[4], bv[4];
#pragma unroll
    for (int j = 0; j < 4; ++j) { gv[j] = ((const f32x4*)g)[lane + 64 * j]; bv[j] = ((const f32x4*)b)[lane + 64 * j]; }
    for (int m = gw; m < M; m += NGW) {
        const f32x4* zr = (const f32x4*)(Z + (size_t)m * DM) + lane;
        f32x4 v[4]; float s = 0.f;
#pragma unroll
        for (int j = 0; j < 4; ++j) { v[j] = zr[64 * j]; s += (v[j].x + v[j].y) + (v[j].z + v[j].w); }
        const float mean = wave_sum(s) * (1.f / DM); float s2 = 0.f;
#pragma unroll
        for (int j = 0; j < 4; ++j) { v[j] = v[j] - mean; s2 += (v[j].x * v[j].x + v[j].y * v[j].y) + (v[j].z * v[j].z + v[j].w * v[j].w); }
        const float rstd = 1.f / sqrtf(wave_sum(s2) * (1.f / DM) + 1e-5f);
        f32x4* xo = (f32x4*)(X + (size_t)m * DM) + lane; unsigned long long* o8 = (unsigned long long*)(XB + (size_t)m * DM) + lane;
#pragma unroll
        for (int j = 0; j < 4; ++j) { const f32x4 o = v[j] * rstd * gv[j] + bv[j]; xo[64 * j] = o; o8[64 * j] = (unsigned long long)pk2(o.x, o.y) | ((unsigned long long)pk2(o.z, o.w) << 32); }
    }
}

__device__ __forceinline__ void stage_iT(LAS bf16* IT, const bf16* I, size_t r0, int h, int tid) {
    for (int ch = tid; ch < 1024; ch += NTHR) { const int s = ch >> 4, v0 = (ch & 15) * 8;
        const v4u w = *(const v4u*)(I + (r0 + s) * 512 + h * 128 + v0);
        IT[(v0 + 0) * 72 + s] = (bf16)(w.x & 0xffff); IT[(v0 + 1) * 72 + s] = (bf16)(w.x >> 16); IT[(v0 + 2) * 72 + s] = (bf16)(w.y & 0xffff); IT[(v0 + 3) * 72 + s] = (bf16)(w.y >> 16);
        IT[(v0 + 4) * 72 + s] = (bf16)(w.z & 0xffff); IT[(v0 + 5) * 72 + s] = (bf16)(w.z >> 16); IT[(v0 + 6) * 72 + s] = (bf16)(w.w & 0xffff); IT[(v0 + 7) * 72 + s] = (bf16)(w.w >> 16); }
}

__device__ __forceinline__ void hgrn_p1(LAS unsigned char* lds, int unit, unsigned char* ws, int tid) {
    const int lane = tid & 63, wid = tid >> 6;
    const int c = unit & 31, bh = unit >> 5, h = bh & 3, b = bh >> 2;
    const size_t r0 = (size_t)b * SEQ + c * 64;
    const int k = tid & 127, seg = tid >> 7;
    const float* LF = (const float*)(ws + WS_LF); bf16* Q = (bf16*)(ws + WS_Q); bf16* KB = (bf16*)(ws + WS_KB); bf16* QD = (bf16*)(ws + WS_QD); const bf16* I = (const bf16*)(ws + WS_I);
    float* DS = (float*)(ws + WS_DS); float* DEC = (float*)(ws + WS_DEC);
    LAS float* tot = (LAS float*)lds; LAS bf16* KT = (LAS bf16*)(lds + 2048); LAS bf16* IT = (LAS bf16*)(lds + 2048 + 18432);
    float lf[16];
#pragma unroll
    for (int j = 0; j < 16; ++j) lf[j] = LF[(r0 + seg * 16 + j) * 512 + h * 128 + k];
    float qv[16], kv[16];
#pragma unroll
    for (int j = 0; j < 16; ++j) { const size_t idx = (r0 + seg * 16 + j) * 512 + h * 128 + k; qv[j] = bf2f(Q[idx]); kv[j] = bf2f(KB[idx]); }
#pragma unroll
    for (int j = 1; j < 16; ++j) lf[j] += lf[j - 1];
    tot[seg * 128 + k] = lf[15];
    stage_iT(IT, I, r0, h, tid);
    __syncthreads();
    const float t0 = tot[k], t1 = tot[128 + k], t2 = tot[256 + k], t3 = tot[384 + k];
    const float off = seg == 0 ? 0.f : (seg == 1 ? t0 : (seg == 2 ? t0 + t1 : t0 + t1 + t2));
    const float bmid = t0 + t1, blast = (t0 + t1) + (t2 + t3);
    unsigned kh[8];
#pragma unroll
    for (int j = 0; j < 16; ++j) { const float bb = off + lf[j]; const size_t idx = (r0 + seg * 16 + j) * 512 + h * 128 + k;
        Q[idx] = (bf16)f2bf(qv[j] * __expf(fminf(bb - bmid, 80.f))); KB[idx] = (bf16)f2bf(kv[j] * __expf(fminf(bmid - bb, 80.f))); QD[idx] = (bf16)f2bf(qv[j] * __expf(bb));
        const unsigned hb = f2bf(kv[j] * __expf(blast - bb)); if (j & 1) kh[j >> 1] |= hb << 16; else kh[j >> 1] = hb; }
    *(LAS v4u*)(KT + k * 72 + seg * 16) = (v4u){kh[0], kh[1], kh[2], kh[3]}; *(LAS v4u*)(KT + k * 72 + seg * 16 + 8) = (v4u){kh[4], kh[5], kh[6], kh[7]};
    if (seg == 0) DEC[(size_t)unit * 128 + k] = __expf(blast);
    __syncthreads();
    f32x4 acc[8];
#pragma unroll
    for (int nb = 0; nb < 8; ++nb) acc[nb] = (f32x4){0.f, 0.f, 0.f, 0.f};
    const int fr = lane & 15, fq = lane >> 4;
#pragma unroll
    for (int ks = 0; ks < 2; ++ks) { const bf16x8 a = *(const LAS bf16x8*)(KT + (16 * wid + fr) * 72 + ks * 32 + 8 * fq);
#pragma unroll
        for (int nb = 0; nb < 8; ++nb) { const bf16x8 bb = *(const LAS bf16x8*)(IT + (16 * nb + fr) * 72 + ks * 32 + 8 * fq); acc[nb] = __builtin_amdgcn_mfma_f32_16x16x32_bf16(a, bb, acc[nb], 0, 0, 0); } }
#pragma unroll
    for (int nb = 0; nb < 8; ++nb) *(f32x4*)(DS + (size_t)unit * 16384 + (16 * nb + fr) * 128 + 16 * wid + 4 * fq) = acc[nb];
    __syncthreads();
}

__device__ __forceinline__ void hgrn_scan(unsigned char* ws, int tid, int bid, int G) {
    float* DS = (float*)(ws + WS_DS); const float* DEC = (const float*)(ws + WS_DEC);
    for (int ch = bid * NTHR + tid; ch < 32 * 4096; ch += G * NTHR) {
        const int bh = ch >> 12, e4 = ch & 4095, k4 = e4 & 31;
        float* base = DS + (size_t)bh * 32 * 16384 + e4 * 4; const float* dbase = DEC + (size_t)bh * 32 * 128 + k4 * 4;
        f32x4 S = (f32x4){0.f, 0.f, 0.f, 0.f};
#pragma unroll 8
        for (int c = 0; c < 32; ++c) { const f32x4 d = *(const f32x4*)(base + (size_t)c * 16384); const f32x4 dc = *(const f32x4*)(dbase + c * 128); *(f32x4*)(base + (size_t)c * 16384) = S; S = dc * S + d; }
    }
}

__device__ __forceinline__ void hgrn_p3(LAS unsigned char* lds, int unit, unsigned char* ws, const float* gnorm, int tid) {
    const int lane = tid & 63, wid = tid >> 6, fr = lane & 15, fq = lane >> 4;
    const int c = unit & 31, bh = unit >> 5, h = bh & 3, b = bh >> 2;
    const size_t r0 = (size_t)b * SEQ + c * 64;
    const bf16* Q = (const bf16*)(ws + WS_Q); const bf16* KB = (const bf16*)(ws + WS_KB); const bf16* QD = (const bf16*)(ws + WS_QD); const bf16* I = (const bf16*)(ws + WS_I);
    bf16* G = (bf16*)(ws + WS_G); const float* DS = (const float*)(ws + WS_DS);
    LAS bf16* QT = (LAS bf16*)lds; LAS bf16* KT = (LAS bf16*)(lds + 17408); LAS bf16* QDs = (LAS bf16*)(lds + 34816); LAS bf16* IT = (LAS bf16*)(lds + 52224);
    LAS bf16* ST = (LAS bf16*)(lds + 70656); LAS bf16* PS = (LAS bf16*)(lds + 105472); LAS float* RED = (LAS float*)(lds + 114688);
    for (int ch = tid; ch < 1024; ch += NTHR) { const int row = ch >> 4, cc = (ch & 15) * 8; const size_t idx = (r0 + row) * 512 + h * 128 + cc;
        *(LAS v4u*)(QT + row * 136 + cc) = *(const v4u*)(Q + idx); *(LAS v4u*)(KT + row * 136 + cc) = *(const v4u*)(KB + idx); *(LAS v4u*)(QDs + row * 136 + cc) = *(const v4u*)(QD + idx); }
    stage_iT(IT, I, r0, h, tid);
    for (int ch = tid; ch < 4096; ch += NTHR) { const int v = ch >> 5, k4 = (ch & 31) * 4; const f32x4 s = *(const f32x4*)(DS + (size_t)unit * 16384 + v * 128 + k4);
        *(LAS v2u*)(ST + v * 136 + k4) = (v2u){pk2(s.x, s.y), pk2(s.z, s.w)}; }
    __syncthreads();
    {
        const int sb = wid >> 1, tb0 = (wid & 1) * 2;
        f32x4 sc[2] = {(f32x4){0.f, 0.f, 0.f, 0.f}, (f32x4){0.f, 0.f, 0.f, 0.f}};
#pragma unroll
        for (int ks = 0; ks < 4; ++ks) { const bf16x8 a = *(const LAS bf16x8*)(KT + (16 * sb + fr) * 136 + ks * 32 + 8 * fq);
#pragma unroll
            for (int j = 0; j < 2; ++j) { const bf16x8 bq = *(const LAS bf16x8*)(QT + (16 * (tb0 + j) + fr) * 136 + ks * 32 + 8 * fq); sc[j] = __builtin_amdgcn_mfma_f32_16x16x32_bf16(a, bq, sc[j], 0, 0, 0); } }
#pragma unroll
        for (int j = 0; j < 2; ++j) { const int t = 16 * (tb0 + j) + fr, s0 = 16 * sb + 4 * fq;
            const float p0 = (s0 + 0 <= t) ? sc[j][0] : 0.f, p1 = (s0 + 1 <= t) ? sc[j][1] : 0.f, p2 = (s0 + 2 <= t) ? sc[j][2] : 0.f, p3 = (s0 + 3 <= t) ? sc[j][3] : 0.f;
            *(LAS v2u*)(PS + t * 72 + s0) = (v2u){pk2(p0, p1), pk2(p2, p3)}; }
    }
    __syncthreads();
    const int tb = wid & 3, vh = wid >> 2;
    f32x4 acc[4];
#pragma unroll
    for (int i = 0; i < 4; ++i) acc[i] = (f32x4){0.f, 0.f, 0.f, 0.f};
#pragma unroll
    for (int ks = 0; ks < 2; ++ks) { const bf16x8 bp = *(const LAS bf16x8*)(PS + (16 * tb + fr) * 72 + ks * 32 + 8 * fq);
#pragma unroll
        for (int i = 0; i < 4; ++i) { const bf16x8 a = *(const LAS bf16x8*)(IT + (16 * (vh * 4 + i) + fr) * 72 + ks * 32 + 8 * fq); acc[i] = __builtin_amdgcn_mfma_f32_16x16x32_bf16(a, bp, acc[i], 0, 0, 0); } }
#pragma unroll
    for (int ks = 0; ks < 4; ++ks) { const bf16x8 bq = *(const LAS bf16x8*)(QDs + (16 * tb + fr) * 136 + ks * 32 + 8 * fq);
#pragma unroll
        for (int i = 0; i < 4; ++i) { const bf16x8 a = *(const LAS bf16x8*)(ST + (16 * (vh * 4 + i) + fr) * 136 + ks * 32 + 8 * fq); acc[i] = __builtin_amdgcn_mfma_f32_16x16x32_bf16(a, bq, acc[i], 0, 0, 0); } }
    float ss = 0.f;
#pragma unroll
    for (int i = 0; i < 4; ++i) ss += (acc[i][0] * acc[i][0] + acc[i][1] * acc[i][1]) + (acc[i][2] * acc[i][2] + acc[i][3] * acc[i][3]);
    ss += __shfl_xor(ss, 16); ss += __shfl_xor(ss, 32);
    if (lane < 16) RED[vh * 64 + 16 * tb + lane] = ss;
    __syncthreads();
    const int t = 16 * tb + fr;
    const float rinv = 1.0f / sqrtf((RED[t] + RED[64 + t]) * (1.0f / 128.0f) + 1e-6f);
#pragma unroll
    for (int i = 0; i < 4; ++i) { const int v0 = 16 * (vh * 4 + i) + 4 * fq; const f32x4 gn = *(const f32x4*)(gnorm + h * 128 + v0);
        bf16* gp = G + (r0 + t) * 512 + h * 128 + v0; const v2u gg = *(const v2u*)gp;
        const float o0 = acc[i][0] * rinv * gn.x * bf2f(gg.x & 0xffff), o1 = acc[i][1] * rinv * gn.y * bf2f(gg.x >> 16), o2 = acc[i][2] * rinv * gn.z * bf2f(gg.y & 0xffff), o3 = acc[i][3] * rinv * gn.w * bf2f(gg.y >> 16);
        *(v2u*)gp = (v2u){pk2(o0, o1), pk2(o2, o3)}; }
    __syncthreads();
}

__device__ __forceinline__ void sgu_unit(LAS unsigned char* lds, int unit, unsigned char* ws, const float* lng, const float* lnb, const float* wsl, const float* bsl, int tid) {
    const int lane = tid & 63, wid = tid >> 6, fr = lane & 15, fq = lane >> 4;
    const int g = unit & 3, n = (unit >> 2) & 15, b = unit >> 6;
    const size_t r0 = (size_t)b * SEQ + n * 128;
    const bf16* V = (const bf16*)(ws + WS_V); bf16* U = (bf16*)(ws + WS_U);
    LAS bf16* W = (LAS bf16*)lds; LAS bf16* VT = (LAS bf16*)(lds + 34816); LAS float* STATS = (LAS float*)(lds + 69632);
    {
        const int row = tid >> 2, part = tid & 3; const v4u* vp = (const v4u*)(V + (r0 + row) * 512 + part * 128);
        float s = 0.f, q = 0.f;
#pragma unroll
        for (int j = 0; j < 16; ++j) { const v4u w = vp[j]; const float a0 = bf2f(w.x & 0xffff), a1 = bf2f(w.x >> 16), a2 = bf2f(w.y & 0xffff), a3 = bf2f(w.y >> 16), a4 = bf2f(w.z & 0xffff), a5 = bf2f(w.z >> 16), a6 = bf2f(w.w & 0xffff), a7 = bf2f(w.w >> 16);
            s += ((a0 + a1) + (a2 + a3)) + ((a4 + a5) + (a6 + a7)); q += ((a0 * a0 + a1 * a1) + (a2 * a2 + a3 * a3)) + ((a4 * a4 + a5 * a5) + (a6 * a6 + a7 * a7)); }
        s += __shfl_xor(s, 1); s += __shfl_xor(s, 2); q += __shfl_xor(q, 1); q += __shfl_xor(q, 2);
        const float mean = s * (1.f / 512.f), var = fmaxf(q * (1.f / 512.f) - mean * mean, 0.f);
        if (part == 0) { STATS[2 * row] = mean; STATS[2 * row + 1] = 1.0f / sqrtf(var + 1e-5f); }
    }
    const float* wg = wsl + (size_t)g * 128 * 128;
    for (int ch = tid; ch < 4096; ch += NTHR) { const int t = ch >> 5, s4 = (ch & 31) * 4; const f32x4 w = *(const f32x4*)(wg + t * 128 + s4);
        *(LAS v2u*)(W + t * 136 + s4) = (v2u){pk2(s4 + 0 <= t ? w.x : 0.f, s4 + 1 <= t ? w.y : 0.f), pk2(s4 + 2 <= t ? w.z : 0.f, s4 + 3 <= t ? w.w : 0.f)}; }
    __syncthreads();
    for (int ch = tid; ch < 2048; ch += NTHR) { const int s = ch >> 4, c0 = (ch & 15) * 8; const v4u w = *(const v4u*)(V + (r0 + s) * 512 + g * 128 + c0);
        const float mean = STATS[2 * s], rstd = STATS[2 * s + 1];
        const f32x4 g0 = *(const f32x4*)(lng + g * 128 + c0), g1 = *(const f32x4*)(lng + g * 128 + c0 + 4), b0 = *(const f32x4*)(lnb + g * 128 + c0), b1 = *(const f32x4*)(lnb + g * 128 + c0 + 4);
        VT[(c0 + 0) * 136 + s] = (bf16)f2bf((bf2f(w.x & 0xffff) - mean) * rstd * g0.x + b0.x); VT[(c0 + 1) * 136 + s] = (bf16)f2bf((bf2f(w.x >> 16) - mean) * rstd * g0.y + b0.y);
        VT[(c0 + 2) * 136 + s] = (bf16)f2bf((bf2f(w.y & 0xffff) - mean) * rstd * g0.z + b0.z); VT[(c0 + 3) * 136 + s] = (bf16)f2bf((bf2f(w.y >> 16) - mean) * rstd * g0.w + b0.w);
        VT[(c0 + 4) * 136 + s] = (bf16)f2bf((bf2f(w.z & 0xffff) - mean) * rstd * g1.x + b1.x); VT[(c0 + 5) * 136 + s] = (bf16)f2bf((bf2f(w.z >> 16) - mean) * rstd * g1.y + b1.y);
        VT[(c0 + 6) * 136 + s] = (bf16)f2bf((bf2f(w.w & 0xffff) - mean) * rstd * g1.z + b1.z); VT[(c0 + 7) * 136 + s] = (bf16)f2bf((bf2f(w.w >> 16) - mean) * rstd * g1.w + b1.w); }
    __syncthreads();
    f32x4 acc[8];
#pragma unroll
    for (int cb = 0; cb < 8; ++cb) acc[cb] = (f32x4){0.f, 0.f, 0.f, 0.f};
#pragma unroll
    for (int ks = 0; ks < 4; ++ks) { const bf16x8 bw = *(const LAS bf16x8*)(W + (16 * wid + fr) * 136 + ks * 32 + 8 * fq);
#pragma unroll
        for (int cb = 0; cb < 8; ++cb) { const bf16x8 a = *(const LAS bf16x8*)(VT + (16 * cb + fr) * 136 + ks * 32 + 8 * fq); acc[cb] = __builtin_amdgcn_mfma_f32_16x16x32_bf16(a, bw, acc[cb], 0, 0, 0); } }
    const int t = 16 * wid + fr; const float bias = bsl[g * 128 + t];
#pragma unroll
    for (int cb = 0; cb < 8; ++cb) { bf16* up = U + (r0 + t) * 512 + g * 128 + 16 * cb + 4 * fq; const v2u uu = *(const v2u*)up;
        *(v2u*)up = (v2u){pk2(bf2f(uu.x & 0xffff) * (acc[cb][0] + bias), bf2f(uu.x >> 16) * (acc[cb][1] + bias)), pk2(bf2f(uu.y & 0xffff) * (acc[cb][2] + bias), bf2f(uu.y >> 16) * (acc[cb][3] + bias))}; }
    __syncthreads();
}
constexpr int NPH_L = 14, NPH = NPH_L * DEPTH;
#ifndef MK_MULTI
#define MK_MULTI 0
#endif

__global__ void __launch_bounds__(NTHR, 2) fwd_kernel(P p) {
    extern __shared__ __attribute__((aligned(16))) unsigned char lds_raw[];
    LAS unsigned char* lds = (LAS unsigned char*)lds_raw;
    unsigned char* ws = p.ws;
    bf16* XB = (bf16*)(ws + WS_XB); bf16* H = (bf16*)(ws + WS_H); float* Z = (float*)(ws + WS_Z);
    for (int ph = p.ph_lo; ph < p.ph_hi; ++ph) {
        int tid = threadIdx.x; asm volatile("" : "+v"(tid));
        const int lane = tid & 63, wave = __builtin_amdgcn_readfirstlane(tid >> 6);
        int bid = blockIdx.x; asm volatile("" : "+s"(bid));
        const int G = gridDim.x, gw = bid * NWAVES + wave, NGW = G * NWAVES;
        const int l = ph / NPH_L, q = ph - l * NPH_L;
        if (q == 0) {
            phase_weights(p, l, lds, gw, NGW, wave, lane);
            if (l == 0) phase_x0(p, gw, NGW, lane, tid, bid);
        } else if (q == 1 || q == 11) {
            pg8::Gemm g{XB, (const bf16*)(ws + (q == 1 ? WS_W13A : WS_W13B)), M, 2 * DFF, DM}; pg8::StaticOrder S; S.init(M, 2 * DFF, G, bid);
            pg8::EpiSwiGLU E{H, DFF};
            pg8::gemm_phase<pg8::EpiSwiGLU, pg8::StaticOrder, true, true>(lds, g, S, E, tid);
        } else if (q == 2 || q == 12) {
            pg8::Gemm g{H, (const bf16*)(ws + (q == 2 ? WS_W2A : WS_W2B)), M, DM, DFF}; pg8::StaticOrder S; S.init(M, DM, G, bid);
            pg8::EpiResid E{(ph == 2) ? p.x : p.out, Z, ALPHA, 0.5f};
            pg8::gemm_phase<pg8::EpiResid, pg8::StaticOrder, true, true>(lds, g, S, E, tid);
        } else if (q == 3 || q == 10 || q == 13) {
            const int j = (q == 3) ? 0 : (q == 10 ? 1 : 2);
            phase_ln(Z, p.ln_g + (size_t)(l * 3 + j) * DM, p.ln_b + (size_t)(l * 3 + j) * DM, p.out, XB, gw, NGW, lane);
        } else if (q == 4) {
            pg8::Gemm g{XB, (const bf16*)(ws + WS_WIN), M, DIN, DM}; pg8::StaticOrder S; S.init(M, DIN, G, bid);
            pg8::EpiInProj E{(bf16*)(ws + WS_Q), (bf16*)(ws + WS_KB), (bf16*)(ws + WS_I), (bf16*)(ws + WS_G), (bf16*)(ws + WS_U), (bf16*)(ws + WS_V), (bf16*)(ws + WS_GA), (bf16*)(ws + WS_GB),
                             (float*)(ws + WS_LF), (const float*)(ws + WS_LB) + l * 512};
            pg8::gemm_phase<pg8::EpiInProj, pg8::StaticOrder, true, true>(lds, g, S, E, tid);
        } else if (q == 5) {
            for (int u = bid; u < 1024 + 512; u += G) {
                if (u < 1024) hgrn_p1(lds, u, ws, tid);
                else sgu_unit(lds, u - 1024, ws, p.sg_ln_g + l * 512, p.sg_ln_b + l * 512, p.sg_ws + (size_t)l * 4 * 128 * 128, p.sg_bs + l * 512, tid);
            }
        } else if (q == 6) {
            hgrn_scan(ws, tid, bid, G);
        } else if (q == 7) {
            for (int u = bid; u < 1024; u += G) hgrn_p3(lds, u, ws, p.hg_norm_g + l * 512, tid);
        } else if (q == 8) {
            { pg8::Gemm g{(const bf16*)(ws + WS_G), (const bf16*)(ws + WS_WA), M, DM, 512}; pg8::StaticOrder S; S.init(M, DM, G, bid);
              pg8::EpiBranchA E{(const bf16*)(ws + WS_GA), (float*)(ws + WS_DS)};
              pg8::gemm_phase<pg8::EpiBranchA, pg8::StaticOrder, true, true>(lds, g, S, E, tid); }
            { pg8::Gemm g{(const bf16*)(ws + WS_U), (const bf16*)(ws + WS_WB), M, DM, 512}; pg8::StaticOrder S; S.init(M, DM, G, bid);
              pg8::EpiBranchB E{(bf16*)(ws + WS_GB), (const float*)(ws + WS_DS)};
              pg8::gemm_phase<pg8::EpiBranchB, pg8::StaticOrder, true, true>(lds, g, S, E, tid); }
        } else if (q == 9) {
            pg8::Gemm g{(const bf16*)(ws + WS_GB), (const bf16*)(ws + WS_WOUT), M, DM, DM}; pg8::StaticOrder S; S.init(M, DM, G, bid);
            pg8::EpiResid E{p.out, Z, ALPHA, 1.0f};
            pg8::gemm_phase<pg8::EpiResid, pg8::StaticOrder, true, true>(lds, g, S, E, tid);
        }
        if (ph + 1 < p.ph_hi) { cg::this_grid().sync(); }
    }
}

extern "C" void kernel_launch(void* const* d_in, const int* in_sizes, int n_in, void* d_out, int out_size, void* d_ws, size_t ws_size, hipStream_t stream) {
    static int grid = 0;
    if (grid == 0) {
        int dev = 0, cus = 0, per_cu = 0;
        if (n_in != 17 || ws_size < WS_END) { fprintf(stderr, "kernel_launch: unexpected inputs (n_in %d, ws %zu)\n", n_in, ws_size); grid = -1; return; }
        (void)hipGetDevice(&dev); (void)hipDeviceGetAttribute(&cus, hipDeviceAttributeMultiprocessorCount, dev);
        if (hipFuncSetAttribute((const void*)fwd_kernel, hipFuncAttributeMaxDynamicSharedMemorySize, LDS_BYTES) != hipSuccess) { fprintf(stderr, "hipFuncSetAttribute failed\n"); grid = -1; return; }
        if (hipOccupancyMaxActiveBlocksPerMultiprocessor(&per_cu, (const void*)fwd_kernel, NTHR, LDS_BYTES) != hipSuccess || per_cu < 1) { fprintf(stderr, "occupancy query: %d\n", per_cu); per_cu = 1; }
        (void)hipGetLastError();
        grid = cus * per_cu;
    }
    if (grid < 0) return;
    P p{};
    p.x = (const float*)d_in[0]; p.ffn1_w13 = (const float*)d_in[1]; p.ffn1_w2 = (const float*)d_in[2]; p.ffn2_w13 = (const float*)d_in[3]; p.ffn2_w2 = (const float*)d_in[4];
    p.ln_g = (const float*)d_in[5]; p.ln_b = (const float*)d_in[6]; p.w_in = (const float*)d_in[7]; p.hg_lb = (const float*)d_in[8]; p.hg_norm_g = (const float*)d_in[9];
    p.sg_ln_g = (const float*)d_in[10]; p.sg_ln_b = (const float*)d_in[11]; p.sg_ws = (const float*)d_in[12]; p.sg_bs = (const float*)d_in[13];
    p.w_a = (const float*)d_in[14]; p.w_b = (const float*)d_in[15]; p.w_out = (const float*)d_in[16];
    p.out = (float*)d_out; p.ws = (unsigned char*)d_ws;
#if MK_MULTI
    for (int ph = 0; ph < NPH; ++ph) { p.ph_lo = ph; p.ph_hi = ph + 1; hipLaunchKernelGGL(fwd_kernel, dim3(grid), dim3(NTHR), LDS_BYTES, stream, p); }
#else
    p.ph_lo = 0; p.ph_hi = NPH;
    void* args[] = {&p};
    hipError_t e = hipLaunchCooperativeKernel((const void*)fwd_kernel, dim3(grid), dim3(NTHR), args, LDS_BYTES, stream);
    if (e != hipSuccess) fprintf(stderr, "cooperative launch failed: %s (grid %d)\n", hipGetErrorString(e), grid);
#endif
}
```

```cpp
#include <hip/hip_runtime.h>
#include <cstdio>
#include <cstdint>
namespace pg8 {
#define PG8_LAS __attribute__((address_space(3)))
typedef unsigned short bf16_t;
typedef short bf16x8 __attribute__((ext_vector_type(8)));
typedef float f32x4 __attribute__((ext_vector_type(4)));
typedef unsigned u32x4 __attribute__((ext_vector_type(4)));
constexpr int BM = 256, BK = 64, HALF = 128, HTB = HALF * BK * 2  , STAGE_BYTES = 8 * HTB, NXCD = 8, WGM = 8;

__host__ __device__ __forceinline__ int lds_byte(int r, int c) { const int st = (r >> 4) * 2 + (c >> 5), rr = r & 15, cc = c & 31, ob = rr * 64 + cc * 2; return st * 1024 + (ob ^ (((ob >> 9) & 1) << 5)); }
__host__ __device__ __forceinline__ void stage_rc(int b, int& R, int& C) { const int st = b / 1024, sb = b % 1024, swz = sb ^ (((sb >> 9) & 1) << 5); R = (st >> 1) * 16 + swz / 64; C = (st & 1) * 32 + (swz % 64) / 2; }
__host__ __device__ __forceinline__ int perm32(int rho) { const int n = rho >> 4, i = rho & 15; return 8 * (i >> 2) + 4 * n + (i & 3); }

struct Unit { int pm, pn; };
struct Gemm { const bf16_t* A; const bf16_t* Bt; int M, N, K; };

struct StaticOrder {
    int nM, nN, nwg, G, c;
    __host__ __device__ void init(int M, int N, int G_, int c_) { nM = M / BM; nN = N / BM; nwg = nM * nN; G = G_; c = c_; }
    __host__ __device__ bool next(int i, Unit& u) const {
        const long L = (long)i * G + c; if (L >= nwg) return false;
        int wgid = (int)L; { const int q = nwg / NXCD, r = nwg % NXCD, xcd = wgid % NXCD, off = wgid / NXCD; wgid = (xcd < r ? xcd * (q + 1) : r * (q + 1) + (xcd - r) * q) + off; }
        const int nig = WGM * nN, gid = wgid / nig, fm = gid * WGM, gsz = (nM - fm) < WGM ? (nM - fm) : WGM;
        u.pm = fm + ((wgid % nig) % gsz); u.pn = (wgid % nig) / gsz; return true;
    }
    __device__ __forceinline__ void a_ready(const Unit&) const {}
    __device__ __forceinline__ void done(const Unit&) const {}
};

__device__ __forceinline__ unsigned cvt_pk_bf16(float lo, float hi) { unsigned r; asm volatile("s_nop 0\n\tv_cvt_pk_bf16_f32 %0, %1, %2" : "=v"(r) : "v"(lo), "v"(hi)); return r; }
typedef float f32x2 __attribute__((ext_vector_type(2)));
__device__ __forceinline__ f32x2 gelu_pk(f32x2 v) {
    const f32x2 av = __builtin_elementwise_abs(v), d = av * 0.2316418882f + 1.0f;
    f32x2 t; t.x = __builtin_amdgcn_rcpf(d.x); t.y = __builtin_amdgcn_rcpf(d.y);
    f32x2 q = t * 0.5307027145f + (-0.7265760135f); q = q * t + 0.7107068705f; q = q * t + (-0.142248368f); q = q * t + 0.127414796f; q = q * t;
    const f32x2 s = (v * v) * (-0.72134752044f);
    f32x2 e; e.x = __builtin_amdgcn_exp2f(s.x); e.y = __builtin_amdgcn_exp2f(s.y);
    const f32x2 m = v * (q * e), r = v - m;
    f32x2 o; o.x = v.x < 0.f ? m.x : r.x; o.y = v.y < 0.f ? m.y : r.y; return o;
}

template <class Epi, class Sched, bool ALIGN_EPI = false, bool SP2 = false>
__device__ __forceinline__ void gemm_phase(PG8_LAS unsigned char* lds, const Gemm g, const Sched& S, const Epi& E, int tid_in) {
    const int tid = tid_in, wid = __builtin_amdgcn_readfirstlane(tid >> 6), lane = tid & 63, wr = wid >> 2, wc = wid & 3, fr = lane & 15, fq = lane >> 4;
    const int K = g.K, nt = K / BK;
    unsigned voffA[2], voffB[2];
#pragma unroll
    for (int i = 0; i < 2; ++i) { int R, C; stage_rc(tid * 16 + i * 8192, R, C); const int Rb = Epi::PERM ? ((R & ~31) + perm32(R & 31)) : R;
        voffA[i] = (unsigned)(R * K + C) * 2u; voffB[i] = (unsigned)(Rb * K + C) * 2u; }
    const size_t kstep = (size_t)(BK * 2);
    const size_t hstep = (size_t)HALF * K * 2;
    const size_t tstep = 2 * hstep;
    const unsigned ldsw = (unsigned)wid * 1024u;
    const int aoff = lds_byte(wr * 64 + fr, fq * 8), boff = lds_byte(wc * 32 + fr, fq * 8);
#define PG8_SA(b, h) (((b) * 2 + (h)) * HTB)
#define PG8_SB(b, h) ((4 + (b) * 2 + (h)) * HTB)
#define PG8_STAGE(bufoff, gbase, voff) do { _Pragma("unroll") for (int _i = 0; _i < 2; ++_i) \
        __builtin_amdgcn_global_load_lds((const unsigned*)((const char*)(gbase) + (voff)[_i]), (PG8_LAS unsigned*)(lds + (bufoff) + ldsw + _i * 8192), 16, 0, 0); } while (0)
#define PG8_LDA(dst, b, h) do { _Pragma("unroll") for (int m = 0; m < 4; ++m) _Pragma("unroll") for (int k = 0; k < 2; ++k) dst[m][k] = *(const PG8_LAS bf16x8*)(lds + PG8_SA(b, h) + aoff + m * 2048 + k * 1024); } while (0)
#define PG8_LDB(dst, b, h) do { _Pragma("unroll") for (int n = 0; n < 2; ++n) _Pragma("unroll") for (int k = 0; k < 2; ++k) dst[n][k] = *(const PG8_LAS bf16x8*)(lds + PG8_SB(b, h) + boff + n * 2048 + k * 1024); } while (0)
#define PG8_MMA(ai, bj, At, Bt) do { __builtin_amdgcn_s_setprio(1); _Pragma("unroll") for (int m = 0; m < 4; ++m) _Pragma("unroll") for (int n = 0; n < 2; ++n) _Pragma("unroll") for (int k = 0; k < 2; ++k) \
        acc[ai][bj][m][n] = __builtin_amdgcn_mfma_f32_16x16x32_bf16(Bt[n][k], At[m][k], acc[ai][bj][m][n], 0, 0, 0); __builtin_amdgcn_s_setprio(0); } while (0)
#define PG8_WAIT_V(n) asm volatile("s_waitcnt vmcnt(" #n ")" ::: "memory")
#define PG8_WAIT_L(n) asm volatile("s_waitcnt lgkmcnt(" #n ")" ::: "memory")
#define PG8_BAR __builtin_amdgcn_s_barrier()
#define PG8_SCHED __builtin_amdgcn_sched_barrier(0)
    Unit cur, nxt; int ui = 0;
    if (!S.next(0, cur)) return;
    f32x4 acc[2][2][4][2];
#pragma unroll
    for (int a = 0; a < 2; ++a)
#pragma unroll
        for (int b = 0; b < 2; ++b)
#pragma unroll
            for (int m = 0; m < 4; ++m)
#pragma unroll
                for (int n = 0; n < 2; ++n) acc[a][b][m][n] = (f32x4){0.f, 0.f, 0.f, 0.f};
    bf16x8 At[4][2], B0[2][2], B1[2][2];
    const char* cA = (const char*)g.A + (size_t)cur.pm * tstep; const char* cB = (const char*)g.Bt + (size_t)cur.pn * tstep;
    S.a_ready(cur);
    if constexpr (SP2) {
        PG8_STAGE(PG8_SB(0, 0), cB, voffB); PG8_STAGE(PG8_SB(0, 1), cB + hstep, voffB); PG8_STAGE(PG8_SA(0, 0), cA, voffA); PG8_STAGE(PG8_SA(0, 1), cA + hstep, voffA);
        if (wr == 1) PG8_BAR;
        PG8_WAIT_V(2); PG8_BAR;
        PG8_STAGE(PG8_SB(1, 0), cB + kstep, voffB); PG8_STAGE(PG8_SA(1, 0), cA + kstep, voffA); PG8_STAGE(PG8_SB(1, 1), cB + hstep + kstep, voffB);
        PG8_WAIT_V(6); PG8_BAR;
    } else {
        PG8_STAGE(PG8_SB(0, 0), cB, voffB); PG8_STAGE(PG8_SA(0, 0), cA, voffA); PG8_STAGE(PG8_SB(0, 1), cB + hstep, voffB); PG8_STAGE(PG8_SA(0, 1), cA + hstep, voffA);
        if (wr == 1) PG8_BAR;
        PG8_WAIT_V(4); PG8_BAR;
        PG8_STAGE(PG8_SB(1, 0), cB + kstep, voffB); PG8_STAGE(PG8_SA(1, 0), cA + kstep, voffA); PG8_STAGE(PG8_SB(1, 1), cB + hstep + kstep, voffB);
        PG8_WAIT_V(6); PG8_BAR;
    }
    for (;;) {
        const bool has_next = S.next(ui + 1, nxt);
        const char* nA = has_next ? (const char*)g.A + (size_t)nxt.pm * tstep : cA; const char* nB = has_next ? (const char*)g.Bt + (size_t)nxt.pn * tstep : cB;
        for (int t = 0; t < nt; t += 2) {
            const bool last = (t == nt - 2);
            const char* a1 = cA + (size_t)(t + 1) * kstep;
            const char* a2 = last ? nA : cA + (size_t)(t + 2) * kstep; const char* b2 = last ? nB : cB + (size_t)(t + 2) * kstep;
            const char* a3 = a2 + kstep; const char* b3 = b2 + kstep;
            if (last && has_next) S.a_ready(nxt);
            if constexpr (SP2) {
            PG8_LDB(B0, 0, 0); PG8_LDB(B1, 0, 1); PG8_SCHED; PG8_LDA(At, 0, 0); PG8_STAGE(PG8_SA(1, 1), a1 + hstep, voffA);
            PG8_WAIT_V(8); PG8_WAIT_L(0); PG8_BAR; PG8_MMA(0, 0, At, B0); PG8_MMA(0, 1, At, B1); PG8_BAR; PG8_SCHED;
            PG8_LDA(At, 0, 1); PG8_STAGE(PG8_SB(0, 0), b2, voffB); PG8_STAGE(PG8_SB(0, 1), b2 + hstep, voffB); PG8_STAGE(PG8_SA(0, 0), a2, voffA);
            PG8_WAIT_V(8); PG8_WAIT_L(0); PG8_BAR; PG8_MMA(1, 0, At, B0); PG8_MMA(1, 1, At, B1); PG8_BAR; PG8_SCHED;
            PG8_LDB(B0, 1, 0); PG8_LDB(B1, 1, 1); PG8_SCHED; PG8_LDA(At, 1, 0); PG8_STAGE(PG8_SA(0, 1), a2 + hstep, voffA);
            PG8_WAIT_V(8); PG8_WAIT_L(0); PG8_BAR; PG8_MMA(0, 0, At, B0); PG8_MMA(0, 1, At, B1); PG8_BAR; PG8_SCHED;
            PG8_LDA(At, 1, 1); PG8_STAGE(PG8_SB(1, 0), b3, voffB); PG8_STAGE(PG8_SB(1, 1), b3 + hstep, voffB); PG8_STAGE(PG8_SA(1, 0), a3, voffA);
            PG8_WAIT_V(8); PG8_WAIT_L(0); PG8_BAR; PG8_MMA(1, 0, At, B0); PG8_MMA(1, 1, At, B1); PG8_BAR; PG8_SCHED;
            } else {
            PG8_LDB(B0, 0, 0); PG8_SCHED; PG8_LDA(At, 0, 0); PG8_STAGE(PG8_SA(1, 1), a1 + hstep, voffA);
            PG8_WAIT_L(8); PG8_BAR; PG8_WAIT_L(0); PG8_MMA(0, 0, At, B0); PG8_BAR; PG8_SCHED;
            PG8_LDB(B1, 0, 1); PG8_STAGE(PG8_SB(0, 0), b2, voffB);
            PG8_BAR; PG8_WAIT_L(0); PG8_MMA(0, 1, At, B1); PG8_BAR;
            PG8_LDA(At, 0, 1); PG8_STAGE(PG8_SA(0, 0), a2, voffA);
            PG8_BAR; PG8_WAIT_L(0); PG8_MMA(1, 0, At, B0); PG8_BAR; PG8_SCHED;
            PG8_STAGE(PG8_SB(0, 1), b2 + hstep, voffB);
            PG8_WAIT_V(6); PG8_BAR; PG8_MMA(1, 1, At, B1); PG8_BAR;
            PG8_LDB(B0, 1, 0); PG8_SCHED; PG8_LDA(At, 1, 0); PG8_STAGE(PG8_SA(0, 1), a2 + hstep, voffA);
            PG8_WAIT_L(8); PG8_BAR; PG8_WAIT_L(0); PG8_MMA(0, 0, At, B0); PG8_BAR; PG8_SCHED;
            PG8_LDB(B1, 1, 1); PG8_STAGE(PG8_SB(1, 0), b3, voffB);
            PG8_BAR; PG8_WAIT_L(0); PG8_MMA(0, 1, At, B1); PG8_BAR;
            PG8_LDA(At, 1, 1); PG8_STAGE(PG8_SA(1, 0), a3, voffA);
            PG8_BAR; PG8_WAIT_L(0); PG8_MMA(1, 0, At, B0); PG8_BAR; PG8_SCHED;
            PG8_STAGE(PG8_SB(1, 1), b3 + hstep, voffB);
            PG8_WAIT_V(6); PG8_BAR; PG8_MMA(1, 1, At, B1); PG8_BAR;
            }
        }
        if constexpr (ALIGN_EPI) { if (wr == 0) PG8_BAR; }
        if constexpr (!Epi::AFTER_DRAIN) { E(acc, cur, wr, wc, fr, fq); S.done(cur); }
        if (!has_next) break;
#pragma unroll
        for (int a = 0; a < 2; ++a)
#pragma unroll
            for (int b = 0; b < 2; ++b)
#pragma unroll
                for (int m = 0; m < 4; ++m)
#pragma unroll
                    for (int n = 0; n < 2; ++n) acc[a][b][m][n] = (f32x4){0.f, 0.f, 0.f, 0.f};
        cur = nxt; cA = nA; cB = nB; ++ui;
        if constexpr (ALIGN_EPI) { if (wr == 1) PG8_BAR; }
    }
    PG8_WAIT_V(0);
    if constexpr (!ALIGN_EPI) { if (wr == 0) PG8_BAR; }
    PG8_BAR;
    if constexpr (Epi::AFTER_DRAIN) { E.fused(acc, cur, wr, wc, fr, fq, lds, wid, lane); S.done(cur); }
#undef PG8_SA
#undef PG8_SB
#undef PG8_STAGE
#undef PG8_LDA
#undef PG8_LDB
#undef PG8_MMA
#undef PG8_WAIT_V
#undef PG8_WAIT_L
#undef PG8_BAR
#undef PG8_SCHED
}
}
namespace pg8 {
typedef unsigned u32x2 __attribute__((ext_vector_type(2)));
__device__ __forceinline__ float fsigmoid(float x) { return __builtin_amdgcn_rcpf(1.0f + __expf(-x)); }
__device__ __forceinline__ float fsilu(float x) { return x * fsigmoid(x); }
__device__ __forceinline__ float fgelu_tanh(float x) { const float u = 1.5957691216057308f * (x + 0.044715f * x * x * x); return x * fsigmoid(u); }
__device__ __forceinline__ float bf2f(unsigned short h) { return __uint_as_float(((unsigned)h) << 16); }
__device__ __forceinline__ float bflo(unsigned w) { return __uint_as_float(w << 16); }
__device__ __forceinline__ float bfhi(unsigned w) { return __uint_as_float(w & 0xffff0000u); }

template <class F> __device__ __forceinline__ void epi_bf16(const f32x4 (&acc)[2][2][4][2], bf16_t* base, int ld, int row0, int col0, F f) {
#pragma unroll
    for (int ai = 0; ai < 2; ++ai)
#pragma unroll
        for (int m = 0; m < 4; ++m) { bf16_t* rowp = base + (size_t)(row0 + ai * HALF + m * 16) * ld + col0;
#pragma unroll
            for (int bj = 0; bj < 2; ++bj) { const f32x4 v0 = acc[ai][bj][m][0], v1 = acc[ai][bj][m][1];
                u32x4 w; w.x = cvt_pk_bf16(f(v0[0]), f(v0[1])); w.y = cvt_pk_bf16(f(v0[2]), f(v0[3])); w.z = cvt_pk_bf16(f(v1[0]), f(v1[1])); w.w = cvt_pk_bf16(f(v1[2]), f(v1[3]));
                *(u32x4*)(rowp + bj * HALF) = w; } }
}

struct EpiSwiGLU {
    static constexpr bool PERM = true, AFTER_DRAIN = false;
    bf16_t* H; int ldh;
    __device__ __forceinline__ void operator()(const f32x4 (&acc)[2][2][4][2], const Unit& u, int wr, int wc, int fr, int fq) const {
        const int row0 = u.pm * BM + wr * 64 + fr, col0 = u.pn * HALF + wc * 32 + 8 * fq;
#pragma unroll
        for (int ai = 0; ai < 2; ++ai)
#pragma unroll
            for (int m = 0; m < 4; ++m) { bf16_t* rowp = H + (size_t)(row0 + ai * HALF + m * 16) * ldh + col0;
                const f32x4 a0 = acc[ai][0][m][0], a1 = acc[ai][0][m][1], b0 = acc[ai][1][m][0], b1 = acc[ai][1][m][1];
                u32x4 w; w.x = cvt_pk_bf16(fsilu(a0[0]) * b0[0], fsilu(a0[1]) * b0[1]); w.y = cvt_pk_bf16(fsilu(a0[2]) * b0[2], fsilu(a0[3]) * b0[3]);
                w.z = cvt_pk_bf16(fsilu(a1[0]) * b1[0], fsilu(a1[1]) * b1[1]); w.w = cvt_pk_bf16(fsilu(a1[2]) * b1[2], fsilu(a1[3]) * b1[3]);
                *(u32x4*)rowp = w; }
    }
};

struct EpiResid {
    static constexpr bool PERM = true, AFTER_DRAIN = false;
    const float* X; float* Z; float alpha, s;
    __device__ __forceinline__ void operator()(const f32x4 (&acc)[2][2][4][2], const Unit& u, int wr, int wc, int fr, int fq) const {
        const int row0 = u.pm * BM + wr * 64 + fr, col0 = u.pn * BM + wc * 32 + 8 * fq;
#pragma unroll
        for (int ai = 0; ai < 2; ++ai)
#pragma unroll
            for (int m = 0; m < 4; ++m) { const size_t off = (size_t)(row0 + ai * HALF + m * 16) * 1024 + col0;
#pragma unroll
                for (int bj = 0; bj < 2; ++bj)
#pragma unroll
                    for (int n = 0; n < 2; ++n) { const f32x4 xv = *(const f32x4*)(X + off + bj * HALF + 4 * n); *(f32x4*)(Z + off + bj * HALF + 4 * n) = xv * alpha + acc[ai][bj][m][n] * s; } }
    }
};

struct EpiInProj {
    static constexpr bool PERM = true, AFTER_DRAIN = false;
    bf16_t *Q, *KB, *I, *G, *U, *V, *GA, *GB; float* LF; const float* LB;
    __device__ __forceinline__ void operator()(const f32x4 (&acc)[2][2][4][2], const Unit& u, int wr, int wc, int fr, int fq) const {
        const int row0 = u.pm * BM + wr * 64 + fr, cw = wc * 32 + 8 * fq, pn = u.pn;
        if (pn < 2) epi_bf16(acc, Q, 512, row0, pn * 256 + cw, [](float v) { return v; });
        else if (pn < 4) {
            const int c0 = (pn - 2) * 256 + cw;
#pragma unroll
            for (int bj = 0; bj < 2; ++bj) {
                const f32x4 l0 = *(const f32x4*)(LB + c0 + bj * HALF), l1 = *(const f32x4*)(LB + c0 + bj * HALF + 4);
#pragma unroll
                for (int ai = 0; ai < 2; ++ai)
#pragma unroll
                    for (int m = 0; m < 4; ++m) { const size_t off = (size_t)(row0 + ai * HALF + m * 16) * 512 + c0 + bj * HALF;
                        const f32x4 v0 = acc[ai][bj][m][0], v1 = acc[ai][bj][m][1]; f32x4 f0, f1, k0, k1;
#pragma unroll
                        for (int i = 0; i < 4; ++i) { const float e0 = __expf(-v0[i]), r0 = __builtin_amdgcn_rcpf(1.0f + e0), e1 = __expf(-v1[i]), r1 = __builtin_amdgcn_rcpf(1.0f + e1);
                            f0[i] = __logf(l0[i] + (1.0f - l0[i]) * r0); k0[i] = (1.0f - l0[i]) * (e0 * r0);
                            f1[i] = __logf(l1[i] + (1.0f - l1[i]) * r1); k1[i] = (1.0f - l1[i]) * (e1 * r1); }
                        *(f32x4*)(LF + off) = f0; *(f32x4*)(LF + off + 4) = f1;
                        u32x4 w; w.x = cvt_pk_bf16(k0[0], k0[1]); w.y = cvt_pk_bf16(k0[2], k0[3]); w.z = cvt_pk_bf16(k1[0], k1[1]); w.w = cvt_pk_bf16(k1[2], k1[3]);
                        *(u32x4*)(KB + off) = w; } }
        }
        else if (pn < 6) epi_bf16(acc, I, 512, row0, (pn - 4) * 256 + cw, [](float v) { return v; });
        else if (pn < 8) epi_bf16(acc, G, 512, row0, (pn - 6) * 256 + cw, [](float v) { return fsilu(v); });
        else if (pn < 10) epi_bf16(acc, U, 512, row0, (pn - 8) * 256 + cw, [](float v) { return fgelu_tanh(v); });
        else if (pn < 12) epi_bf16(acc, V, 512, row0, (pn - 10) * 256 + cw, [](float v) { return fgelu_tanh(v); });
        else if (pn < 16) epi_bf16(acc, GA, 1024, row0, (pn - 12) * 256 + cw, [](float v) { return fsigmoid(v); });
        else epi_bf16(acc, GB, 1024, row0, (pn - 16) * 256 + cw, [](float v) { return fsigmoid(v); });
    }
};

struct EpiBranchA {
    static constexpr bool PERM = true, AFTER_DRAIN = false;
    const bf16_t* GA; float* YP;
    __device__ __forceinline__ void operator()(const f32x4 (&acc)[2][2][4][2], const Unit& u, int wr, int wc, int fr, int fq) const {
        const int row0 = u.pm * BM + wr * 64 + fr, col0 = u.pn * BM + wc * 32 + 8 * fq;
#pragma unroll
        for (int ai = 0; ai < 2; ++ai)
#pragma unroll
            for (int m = 0; m < 4; ++m) { const size_t off = (size_t)(row0 + ai * HALF + m * 16) * 1024 + col0;
#pragma unroll
                for (int bj = 0; bj < 2; ++bj) { const u32x4 g = *(const u32x4*)(GA + off + bj * HALF); const f32x4 v0 = acc[ai][bj][m][0], v1 = acc[ai][bj][m][1];
                    f32x4 o0, o1; o0[0] = bflo(g.x) * v0[0]; o0[1] = bfhi(g.x) * v0[1]; o0[2] = bflo(g.y) * v0[2]; o0[3] = bfhi(g.y) * v0[3];
                    o1[0] = bflo(g.z) * v1[0]; o1[1] = bfhi(g.z) * v1[1]; o1[2] = bflo(g.w) * v1[2]; o1[3] = bfhi(g.w) * v1[3];
                    *(f32x4*)(YP + off + bj * HALF) = o0; *(f32x4*)(YP + off + bj * HALF + 4) = o1; } }
    }
};
struct EpiBranchB {
    static constexpr bool PERM = true, AFTER_DRAIN = false;
    bf16_t* GBY; const float* YP;
    __device__ __forceinline__ void operator()(const f32x4 (&acc)[2][2][4][2], const Unit& u, int wr, int wc, int fr, int fq) const {
        const int row0 = u.pm * BM + wr * 64 + fr, col0 = u.pn * BM + wc * 32 + 8 * fq;
#pragma unroll
        for (int ai = 0; ai < 2; ++ai)
#pragma unroll
            for (int m = 0; m < 4; ++m) { const size_t off = (size_t)(row0 + ai * HALF + m * 16) * 1024 + col0;
#pragma unroll
                for (int bj = 0; bj < 2; ++bj) { const u32x4 g = *(const u32x4*)(GBY + off + bj * HALF); const f32x4 v0 = acc[ai][bj][m][0], v1 = acc[ai][bj][m][1];
                    const f32x4 p0 = *(const f32x4*)(YP + off + bj * HALF), p1 = *(const f32x4*)(YP + off + bj * HALF + 4);
                    u32x4 w; w.x = cvt_pk_bf16(p0[0] + bflo(g.x) * v0[0], p0[1] + bfhi(g.x) * v0[1]); w.y = cvt_pk_bf16(p0[2] + bflo(g.y) * v0[2], p0[3] + bfhi(g.y) * v0[3]);
                    w.z = cvt_pk_bf16(p1[0] + bflo(g.z) * v1[0], p1[1] + bfhi(g.z) * v1[1]); w.w = cvt_pk_bf16(p1[2] + bflo(g.w) * v1[2], p1[3] + bfhi(g.w) * v1[3]);
                    *(u32x4*)(GBY + off + bj * HALF) = w; } }
    }
};
}
#include <hip/hip_cooperative_groups.h>
namespace cg = cooperative_groups;
#define LAS __attribute__((address_space(3)))
typedef unsigned short bf16;
typedef unsigned v4u __attribute__((ext_vector_type(4)));
typedef unsigned v2u __attribute__((ext_vector_type(2)));
typedef float f32x4 __attribute__((ext_vector_type(4)));
typedef short bf16x8 __attribute__((ext_vector_type(8)));

constexpr int NWAVES = 8, NTHR = 512;
constexpr int DM = 1024, BATCH = 8, SEQ = 2048, DEPTH = 4, M = BATCH * SEQ, DFF = 2816, DIN = 5120;
constexpr float ALPHA = 1.681792830507429f;
constexpr size_t MiB = 1u << 20;
constexpr size_t WS_LB = 4096;
constexpr size_t WS_W13A = 2 * MiB, WS_W2A = 13 * MiB, WS_W13B = 19 * MiB, WS_W2B = 30 * MiB, WS_WIN = 36 * MiB, WS_WA = 46 * MiB, WS_WB = 47 * MiB, WS_WOUT = 48 * MiB;
constexpr size_t WS_XB = 50 * MiB;
constexpr size_t WS_BIG = 82 * MiB;
constexpr size_t WS_H = WS_BIG;
constexpr size_t WS_Q = WS_BIG, WS_KB = WS_BIG + 16 * MiB, WS_LF = WS_BIG + 32 * MiB, WS_I = WS_BIG + 64 * MiB, WS_G = WS_BIG + 80 * MiB, WS_U = WS_BIG + 96 * MiB,
                 WS_V = WS_BIG + 112 * MiB, WS_GA = WS_BIG + 128 * MiB, WS_GB = WS_BIG + 160 * MiB, WS_QD = WS_BIG + 192 * MiB, WS_DS = WS_BIG + 208 * MiB, WS_DEC = WS_BIG + 272 * MiB;
constexpr size_t WS_Z = WS_DS;
constexpr size_t WS_END = WS_BIG + 273 * MiB;
constexpr int LDS_BYTES = 147456;

__device__ __forceinline__ unsigned f2bf(float f) { unsigned u = __builtin_bit_cast(unsigned, f); return (u + 0x7fffu + ((u >> 16) & 1u)) >> 16; }
__device__ __forceinline__ unsigned pk2(float lo, float hi) { return f2bf(lo) | (f2bf(hi) << 16); }
__device__ __forceinline__ float bf2f(unsigned h) { return __uint_as_float(h << 16); }
__device__ __forceinline__ float wave_sum(float v) {
#pragma unroll
    for (int o = 1; o < 64; o <<= 1) v += __shfl_xor(v, o);
    return v;
}
#define LDS_WAIT() asm volatile("s_waitcnt lgkmcnt(0)" ::: "memory")

__device__ __forceinline__ void transpose_item(const float* W, int K, int N, bf16* WT, int mode, LAS float* scr, int item, int lane) {
    const int nblk = N / 32, kb = item / nblk, nb = item % nblk, k0 = 64 * kb, n0 = 32 * nb;
    int drow = n0;
    if (mode == 1) { int c = n0; if (c < DFF) drow = (c / 128) * 256 + (c % 128); else { c -= DFF; drow = (c / 128) * 256 + 128 + (c % 128); } }
#pragma unroll 8
    for (int i = 0; i < 32; ++i) { const int kk = 2 * i + (lane >> 5); scr[kk * 33 + (lane & 31)] = W[(size_t)(k0 + kk) * N + n0 + (lane & 31)]; }
    LDS_WAIT(); asm volatile("" ::: "memory");
    const int c = lane & 7;
#pragma unroll
    for (int j = 0; j < 4; ++j) { const int n = (lane >> 3) + 8 * j; const LAS float* s = scr + (8 * c) * 33 + n;
        v4u o; o.x = pk2(s[0 * 33], s[1 * 33]); o.y = pk2(s[2 * 33], s[3 * 33]); o.z = pk2(s[4 * 33], s[5 * 33]); o.w = pk2(s[6 * 33], s[7 * 33]);
        *(v4u*)(WT + (size_t)(drow + n) * K + k0 + 8 * c) = o; }
    LDS_WAIT(); asm volatile("" ::: "memory");
}

struct P {
    const float *x, *ffn1_w13, *ffn1_w2, *ffn2_w13, *ffn2_w2, *ln_g, *ln_b, *w_in, *hg_lb, *hg_norm_g, *sg_ln_g, *sg_ln_b, *sg_ws, *sg_bs, *w_a, *w_b, *w_out;
    float* out; unsigned char* ws; int ph_lo, ph_hi;
};

__device__ __forceinline__ void phase_weights(const P& p, int l, LAS unsigned char* lds, int gw, int NGW, int wave, int lane) {
    LAS float* scr = (LAS float*)(lds + wave * 16384);
    constexpr int I13 = (DM / 64) * (2 * DFF / 32), I2 = (DFF / 64) * (DM / 32), IIN = (DM / 64) * (DIN / 32), IAB = (512 / 64) * (DM / 32), IOUT = (DM / 64) * (DM / 32);
    constexpr int NITEMS = 2 * I13 + 2 * I2 + IIN + 2 * IAB + IOUT;
    unsigned char* ws = p.ws;
    for (int it = gw; it < NITEMS; it += NGW) {
        int r = it;
        if (r < I13) { transpose_item(p.ffn1_w13 + (size_t)l * DM * 2 * DFF, DM, 2 * DFF, (bf16*)(ws + WS_W13A), 1, scr, r, lane); continue; } r -= I13;
        if (r < I13) { transpose_item(p.ffn2_w13 + (size_t)l * DM * 2 * DFF, DM, 2 * DFF, (bf16*)(ws + WS_W13B), 1, scr, r, lane); continue; } r -= I13;
        if (r < I2) { transpose_item(p.ffn1_w2 + (size_t)l * DFF * DM, DFF, DM, (bf16*)(ws + WS_W2A), 0, scr, r, lane); continue; } r -= I2;
        if (r < I2) { transpose_item(p.ffn2_w2 + (size_t)l * DFF * DM, DFF, DM, (bf16*)(ws + WS_W2B), 0, scr, r, lane); continue; } r -= I2;
        if (r < IIN) { transpose_item(p.w_in + (size_t)l * DM * DIN, DM, DIN, (bf16*)(ws + WS_WIN), 0, scr, r, lane); continue; } r -= IIN;
        if (r < IAB) { transpose_item(p.w_a + (size_t)l * 512 * DM, 512, DM, (bf16*)(ws + WS_WA), 0, scr, r, lane); continue; } r -= IAB;
        if (r < IAB) { transpose_item(p.w_b + (size_t)l * 512 * DM, 512, DM, (bf16*)(ws + WS_WB), 0, scr, r, lane); continue; } r -= IAB;
        transpose_item(p.w_out + (size_t)l * DM * DM, DM, DM, (bf16*)(ws + WS_WOUT), 0, scr, r, lane);
    }
}

__device__ __forceinline__ void phase_x0(const P& p, int gw, int NGW, int lane, int tid, int bid) {
    bf16* XB = (bf16*)(p.ws + WS_XB);
    for (int m = gw; m < M; m += NGW) {
        const f32x4* xr = (const f32x4*)(p.x + (size_t)m * DM) + lane; unsigned long long* o8 = (unsigned long long*)(XB + (size_t)m * DM) + lane;
#pragma unroll
        for (int j = 0; j < 4; ++j) { const f32x4 v = xr[64 * j]; o8[64 * j] = (unsigned long long)pk2(v.x, v.y) | ((unsigned long long)pk2(v.z, v.w) << 32); }
    }
    if (bid == 0) {
        float* LB = (float*)(p.ws + WS_LB); const int c = tid;
        float v[4], mx = -1e30f; for (int l = 0; l < 4; ++l) { v[l] = p.hg_lb[l * 512 + c]; mx = fmaxf(mx, v[l]); }
        float s = 0.f; for (int l = 0; l < 4; ++l) { v[l] = expf(v[l] - mx); s += v[l]; }
        float cum = 0.f; const float s0 = v[0] / s;
        for (int l = 0; l < 4; ++l) { cum += v[l] / s; LB[l * 512 + c] = cum - s0; }
    }
}

__device__ __forceinline__ void phase_ln(const float* Z, const float* g, const float* b, float* X, bf16* XB, int gw, int NGW, int lane) {
    f32x4 gv[4], bv[4];
#pragma unroll
    for (int j = 0; j < 4; ++j) { gv[j] = ((const f32x4*)g)[lane + 64 * j]; bv[j] = ((const f32x4*)b)[lane + 64 * j]; }
    for (int m = gw; m < M; m += NGW) {
        const f32x4* zr = (const f32x4*)(Z + (size_t)m * DM) + lane;
        f32x4 v[4]; float s = 0.f;
#pragma unroll
        for (int j = 0; j < 4; ++j) { v[j] = zr[64 * j]; s += (v[j].x + v[j].y) + (v[j].z + v[j].w); }
        const float mean = wave_sum(s) * (1.f / DM); float s2 = 0.f;
#pragma unroll
        for (int j = 0; j < 4; ++j) { v[j] = v[j] - mean; s2 += (v[j].x * v[j].x + v[j].y * v[j].y) + (v[j].z * v[j].z + v[j].w * v[j].w); }
        const float rstd = 1.f / sqrtf(wave_sum(s2) * (1.f / DM) + 1e-5f);
        f32x4* xo = (f32x4*)(X + (size_t)m * DM) + lane; unsigned long long* o8 = (unsigned long long*)(XB + (size_t)m * DM) + lane;
#pragma unroll
        for (int j = 0; j < 4; ++j) { const f32x4 o = v[j] * rstd * gv[j] + bv[j]; xo[64 * j] = o; o8[64 * j] = (unsigned long long)pk2(o.x, o.y) | ((unsigned long long)pk2(o.z, o.w) << 32); }
    }
}

__device__ __forceinline__ void stage_iT(LAS bf16* IT, const bf16* I, size_t r0, int h, int tid) {
    for (int ch = tid; ch < 1024; ch += NTHR) { const int s = ch >> 4, v0 = (ch & 15) * 8;
        const v4u w = *(const v4u*)(I + (r0 + s) * 512 + h * 128 + v0);
        IT[(v0 + 0) * 72 + s] = (bf16)(w.x & 0xffff); IT[(v0 + 1) * 72 + s] = (bf16)(w.x >> 16); IT[(v0 + 2) * 72 + s] = (bf16)(w.y & 0xffff); IT[(v0 + 3) * 72 + s] = (bf16)(w.y >> 16);
        IT[(v0 + 4) * 72 + s] = (bf16)(w.z & 0xffff); IT[(v0 + 5) * 72 + s] = (bf16)(w.z >> 16); IT[(v0 + 6) * 72 + s] = (bf16)(w.w & 0xffff); IT[(v0 + 7) * 72 + s] = (bf16)(w.w >> 16); }
}

__device__ __forceinline__ void hgrn_p1(LAS unsigned char* lds, int unit, unsigned char* ws, int tid) {
    const int lane = tid & 63, wid = tid >> 6;
    const int c = unit & 31, bh = unit >> 5, h = bh & 3, b = bh >> 2;
    const size_t r0 = (size_t)b * SEQ + c * 64;
    const int k = tid & 127, seg = tid >> 7;
    const float* LF = (const float*)(ws + WS_LF); bf16* Q = (bf16*)(ws + WS_Q); bf16* KB = (bf16*)(ws + WS_KB); bf16* QD = (bf16*)(ws + WS_QD); const bf16* I = (const bf16*)(ws + WS_I);
    float* DS = (float*)(ws + WS_DS); float* DEC = (float*)(ws + WS_DEC);
    LAS float* tot = (LAS float*)lds; LAS bf16* KT = (LAS bf16*)(lds + 2048); LAS bf16* IT = (LAS bf16*)(lds + 2048 + 18432);
    float lf[16];
#pragma unroll
    for (int j = 0; j < 16; ++j) lf[j] = LF[(r0 + seg * 16 + j) * 512 + h * 128 + k];
    float qv[16], kv[16];
#pragma unroll
    for (int j = 0; j < 16; ++j) { const size_t idx = (r0 + seg * 16 + j) * 512 + h * 128 + k; qv[j] = bf2f(Q[idx]); kv[j] = bf2f(KB[idx]); }
#pragma unroll
    for (int j = 1; j < 16; ++j) lf[j] += lf[j - 1];
    tot[seg * 128 + k] = lf[15];
    stage_iT(IT, I, r0, h, tid);
    __syncthreads();
    const float t0 = tot[k], t1 = tot[128 + k], t2 = tot[256 + k], t3 = tot[384 + k];
    const float off = seg == 0 ? 0.f : (seg == 1 ? t0 : (seg == 2 ? t0 + t1 : t0 + t1 + t2));
    const float bmid = t0 + t1, blast = (t0 + t1) + (t2 + t3);
    unsigned kh[8];
#pragma unroll
    for (int j = 0; j < 16; ++j) { const float bb = off + lf[j]; const size_t idx = (r0 + seg * 16 + j) * 512 + h * 128 + k;
        Q[idx] = (bf16)f2bf(qv[j] * __expf(fminf(bb - bmid, 80.f))); KB[idx] = (bf16)f2bf(kv[j] * __expf(fminf(bmid - bb, 80.f))); QD[idx] = (bf16)f2bf(qv[j] * __expf(bb));
        const unsigned hb = f2bf(kv[j] * __expf(blast - bb)); if (j & 1) kh[j >> 1] |= hb << 16; else kh[j >> 1] = hb; }
    *(LAS v4u*)(KT + k * 72 + seg * 16) = (v4u){kh[0], kh[1], kh[2], kh[3]}; *(LAS v4u*)(KT + k * 72 + seg * 16 + 8) = (v4u){kh[4], kh[5], kh[6], kh[7]};
    if (seg == 0) DEC[(size_t)unit * 128 + k] = __expf(blast);
    __syncthreads();
    f32x4 acc[8];
#pragma unroll
    for (int nb = 0; nb < 8; ++nb) acc[nb] = (f32x4){0.f, 0.f, 0.f, 0.f};
    const int fr = lane & 15, fq = lane >> 4;
#pragma unroll
    for (int ks = 0; ks < 2; ++ks) { const bf16x8 a = *(const LAS bf16x8*)(KT + (16 * wid + fr) * 72 + ks * 32 + 8 * fq);
#pragma unroll
        for (int nb = 0; nb < 8; ++nb) { const bf16x8 bb = *(const LAS bf16x8*)(IT + (16 * nb + fr) * 72 + ks * 32 + 8 * fq); acc[nb] = __builtin_amdgcn_mfma_f32_16x16x32_bf16(a, bb, acc[nb], 0, 0, 0); } }
#pragma unroll
    for (int nb = 0; nb < 8; ++nb) *(f32x4*)(DS + (size_t)unit * 16384 + (16 * nb + fr) * 128 + 16 * wid + 4 * fq) = acc[nb];
    __syncthreads();
}

__device__ __forceinline__ void hgrn_scan(unsigned char* ws, int tid, int bid, int G) {
    float* DS = (float*)(ws + WS_DS); const float* DEC = (const float*)(ws + WS_DEC);
    for (int ch = bid * NTHR + tid; ch < 32 * 4096; ch += G * NTHR) {
        const int bh = ch >> 12, e4 = ch & 4095, k4 = e4 & 31;
        float* base = DS + (size_t)bh * 32 * 16384 + e4 * 4; const float* dbase = DEC + (size_t)bh * 32 * 128 + k4 * 4;
        f32x4 S = (f32x4){0.f, 0.f, 0.f, 0.f};
#pragma unroll 8
        for (int c = 0; c < 32; ++c) { const f32x4 d = *(const f32x4*)(base + (size_t)c * 16384); const f32x4 dc = *(const f32x4*)(dbase + c * 128); *(f32x4*)(base + (size_t)c * 16384) = S; S = dc * S + d; }
    }
}

__device__ __forceinline__ void hgrn_p3(LAS unsigned char* lds, int unit, unsigned char* ws, const float* gnorm, int tid) {
    const int lane = tid & 63, wid = tid >> 6, fr = lane & 15, fq = lane >> 4;
    const int c = unit & 31, bh = unit >> 5, h = bh & 3, b = bh >> 2;
    const size_t r0 = (size_t)b * SEQ + c * 64;
    const bf16* Q = (const bf16*)(ws + WS_Q); const bf16* KB = (const bf16*)(ws + WS_KB); const bf16* QD = (const bf16*)(ws + WS_QD); const bf16* I = (const bf16*)(ws + WS_I);
    bf16* G = (bf16*)(ws + WS_G); const float* DS = (const float*)(ws + WS_DS);
    LAS bf16* QT = (LAS bf16*)lds; LAS bf16* KT = (LAS bf16*)(lds + 17408); LAS bf16* QDs = (LAS bf16*)(lds + 34816); LAS bf16* IT = (LAS bf16*)(lds + 52224);
    LAS bf16* ST = (LAS bf16*)(lds + 70656); LAS bf16* PS = (LAS bf16*)(lds + 105472); LAS float* RED = (LAS float*)(lds + 114688);
    for (int ch = tid; ch < 1024; ch += NTHR) { const int row = ch >> 4, cc = (ch & 15) * 8; const size_t idx = (r0 + row) * 512 + h * 128 + cc;
        *(LAS v4u*)(QT + row * 136 + cc) = *(const v4u*)(Q + idx); *(LAS v4u*)(KT + row * 136 + cc) = *(const v4u*)(KB + idx); *(LAS v4u*)(QDs + row * 136 + cc) = *(const v4u*)(QD + idx); }
    stage_iT(IT, I, r0, h, tid);
    for (int ch = tid; ch < 4096; ch += NTHR) { const int v = ch >> 5, k4 = (ch & 31) * 4; const f32x4 s = *(const f32x4*)(DS + (size_t)unit * 16384 + v * 128 + k4);
        *(LAS v2u*)(ST + v * 136 + k4) = (v2u){pk2(s.x, s.y), pk2(s.z, s.w)}; }
    __syncthreads();
    {
        const int sb = wid >> 1, tb0 = (wid & 1) * 2;
        f32x4 sc[2] = {(f32x4){0.f, 0.f, 0.f, 0.f}, (f32x4){0.f, 0.f, 0.f, 0.f}};
#pragma unroll
        for (int ks = 0; ks < 4; ++ks) { const bf16x8 a = *(const LAS bf16x8*)(KT + (16 * sb + fr) * 136 + ks * 32 + 8 * fq);
#pragma unroll
            for (int j = 0; j < 2; ++j) { const bf16x8 bq = *(const LAS bf16x8*)(QT + (16 * (tb0 + j) + fr) * 136 + ks * 32 + 8 * fq); sc[j] = __builtin_amdgcn_mfma_f32_16x16x32_bf16(a, bq, sc[j], 0, 0, 0); } }
#pragma unroll
        for (int j = 0; j < 2; ++j) { const int t = 16 * (tb0 + j) + fr, s0 = 16 * sb + 4 * fq;
            const float p0 = (s0 + 0 <= t) ? sc[j][0] : 0.f, p1 = (s0 + 1 <= t) ? sc[j][1] : 0.f, p2 = (s0 + 2 <= t) ? sc[j][2] : 0.f, p3 = (s0 + 3 <= t) ? sc[j][3] : 0.f;
            *(LAS v2u*)(PS + t * 72 + s0) = (v2u){pk2(p0, p1), pk2(p2, p3)}; }
    }
    __syncthreads();
    const int tb = wid & 3, vh = wid >> 2;
    f32x4 acc[4];
#pragma unroll
    for (int i = 0; i < 4; ++i) acc[i] = (f32x4){0.f, 0.f, 0.f, 0.f};
#pragma unroll
    for (int ks = 0; ks < 2; ++ks) { const bf16x8 bp = *(const LAS bf16x8*)(PS + (16 * tb + fr) * 72 + ks * 32 + 8 * fq);
#pragma unroll
        for (int i = 0; i < 4; ++i) { const bf16x8 a = *(const LAS bf16x8*)(IT + (16 * (vh * 4 + i) + fr) * 72 + ks * 32 + 8 * fq); acc[i] = __builtin_amdgcn_mfma_f32_16x16x32_bf16(a, bp, acc[i], 0, 0, 0); } }
#pragma unroll
    for (int ks = 0; ks < 4; ++ks) { const bf16x8 bq = *(const LAS bf16x8*)(QDs + (16 * tb + fr) * 136 + ks * 32 + 8 * fq);
#pragma unroll
        for (int i = 0; i < 4; ++i) { const bf16x8 a = *(const LAS bf16x8*)(ST + (16 * (vh * 4 + i) + fr) * 136 + ks * 32 + 8 * fq); acc[i] = __builtin_amdgcn_mfma_f32_16x16x32_bf16(a, bq, acc[i], 0, 0, 0); } }
    float ss = 0.f;
#pragma unroll
    for (int i = 0; i < 4; ++i) ss += (acc[i][0] * acc[i][0] + acc[i][1] * acc[i][1]) + (acc[i][2] * acc[i][2] + acc[i][3] * acc[i][3]);
    ss += __shfl_xor(ss, 16); ss += __shfl_xor(ss, 32);
    if (lane < 16) RED[vh * 64 + 16 * tb + lane] = ss;
    __syncthreads();
    const int t = 16 * tb + fr;
    const float rinv = 1.0f / sqrtf((RED[t] + RED[64 + t]) * (1.0f / 128.0f) + 1e-6f);
#pragma unroll
    for (int i = 0; i < 4; ++i) { const int v0 = 16 * (vh * 4 + i) + 4 * fq; const f32x4 gn = *(const f32x4*)(gnorm + h * 128 + v0);
        bf16* gp = G + (r0 + t) * 512 + h * 128 + v0; const v2u gg = *(const v2u*)gp;
        const float o0 = acc[i][0] * rinv * gn.x * bf2f(gg.x & 0xffff), o1 = acc[i][1] * rinv * gn.y * bf2f(gg.x >> 16), o2 = acc[i][2] * rinv * gn.z * bf2f(gg.y & 0xffff), o3 = acc[i][3] * rinv * gn.w * bf2f(gg.y >> 16);
        *(v2u*)gp = (v2u){pk2(o0, o1), pk2(o2, o3)}; }
    __syncthreads();
}

__device__ __forceinline__ void sgu_unit(LAS unsigned char* lds, int unit, unsigned char* ws, const float* lng, const float* lnb, const float* wsl, const float* bsl, int tid) {
    const int lane = tid & 63, wid = tid >> 6, fr = lane & 15, fq = lane >> 4;
    const int g = unit & 3, n = (unit >> 2) & 15, b = unit >> 6;
    const size_t r0 = (size_t)b * SEQ + n * 128;
    const bf16* V = (const bf16*)(ws + WS_V); bf16* U = (bf16*)(ws + WS_U);
    LAS bf16* W = (LAS bf16*)lds; LAS bf16* VT = (LAS bf16*)(lds + 34816); LAS float* STATS = (LAS float*)(lds + 69632);
    {
        const int row = tid >> 2, part = tid & 3; const v4u* vp = (const v4u*)(V + (r0 + row) * 512 + part * 128);
        float s = 0.f, q = 0.f;
#pragma unroll
        for (int j = 0; j < 16; ++j) { const v4u w = vp[j]; const float a0 = bf2f(w.x & 0xffff), a1 = bf2f(w.x >> 16), a2 = bf2f(w.y & 0xffff), a3 = bf2f(w.y >> 16), a4 = bf2f(w.z & 0xffff), a5 = bf2f(w.z >> 16), a6 = bf2f(w.w & 0xffff), a7 = bf2f(w.w >> 16);
            s += ((a0 + a1) + (a2 + a3)) + ((a4 + a5) + (a6 + a7)); q += ((a0 * a0 + a1 * a1) + (a2 * a2 + a3 * a3)) + ((a4 * a4 + a5 * a5) + (a6 * a6 + a7 * a7)); }
        s += __shfl_xor(s, 1); s += __shfl_xor(s, 2); q += __shfl_xor(q, 1); q += __shfl_xor(q, 2);
        const float mean = s * (1.f / 512.f), var = fmaxf(q * (1.f / 512.f) - mean * mean, 0.f);
        if (part == 0) { STATS[2 * row] = mean; STATS[2 * row + 1] = 1.0f / sqrtf(var + 1e-5f); }
    }
    const float* wg = wsl + (size_t)g * 128 * 128;
    for (int ch = tid; ch < 4096; ch += NTHR) { const int t = ch >> 5, s4 = (ch & 31) * 4; const f32x4 w = *(const f32x4*)(wg + t * 128 + s4);
        *(LAS v2u*)(W + t * 136 + s4) = (v2u){pk2(s4 + 0 <= t ? w.x : 0.f, s4 + 1 <= t ? w.y : 0.f), pk2(s4 + 2 <= t ? w.z : 0.f, s4 + 3 <= t ? w.w : 0.f)}; }
    __syncthreads();
    for (int ch = tid; ch < 2048; ch += NTHR) { const int s = ch >> 4, c0 = (ch & 15) * 8; const v4u w = *(const v4u*)(V + (r0 + s) * 512 + g * 128 + c0);
        const float mean = STATS[2 * s], rstd = STATS[2 * s + 1];
        const f32x4 g0 = *(const f32x4*)(lng + g * 128 + c0), g1 = *(const f32x4*)(lng + g * 128 + c0 + 4), b0 = *(const f32x4*)(lnb + g * 128 + c0), b1 = *(const f32x4*)(lnb + g * 128 + c0 + 4);
        VT[(c0 + 0) * 136 + s] = (bf16)f2bf((bf2f(w.x & 0xffff) - mean) * rstd * g0.x + b0.x); VT[(c0 + 1) * 136 + s] = (bf16)f2bf((bf2f(w.x >> 16) - mean) * rstd * g0.y + b0.y);
        VT[(c0 + 2) * 136 + s] = (bf16)f2bf((bf2f(w.y & 0xffff) - mean) * rstd * g0.z + b0.z); VT[(c0 + 3) * 136 + s] = (bf16)f2bf((bf2f(w.y >> 16) - mean) * rstd * g0.w + b0.w);
        VT[(c0 + 4) * 136 + s] = (bf16)f2bf((bf2f(w.z & 0xffff) - mean) * rstd * g1.x + b1.x); VT[(c0 + 5) * 136 + s] = (bf16)f2bf((bf2f(w.z >> 16) - mean) * rstd * g1.y + b1.y);
        VT[(c0 + 6) * 136 + s] = (bf16)f2bf((bf2f(w.w & 0xffff) - mean) * rstd * g1.z + b1.z); VT[(c0 + 7) * 136 + s] = (bf16)f2bf((bf2f(w.w >> 16) - mean) * rstd * g1.w + b1.w); }
    __syncthreads();
    f32x4 acc[8];
#pragma unroll
    for (int cb = 0; cb < 8; ++cb) acc[cb] = (f32x4){0.f, 0.f, 0.f, 0.f};
#pragma unroll
    for (int ks = 0; ks < 4; ++ks) { const bf16x8 bw = *(const LAS bf16x8*)(W + (16 * wid + fr) * 136 + ks * 32 + 8 * fq);
#pragma unroll
        for (int cb = 0; cb < 8; ++cb) { const bf16x8 a = *(const LAS bf16x8*)(VT + (16 * cb + fr) * 136 + ks * 32 + 8 * fq); acc[cb] = __builtin_amdgcn_mfma_f32_16x16x32_bf16(a, bw, acc[cb], 0, 0, 0); } }
    const int t = 16 * wid + fr; const float bias = bsl[g * 128 + t];
#pragma unroll
    for (int cb = 0; cb < 8; ++cb) { bf16* up = U + (r0 + t) * 512 + g * 128 + 16 * cb + 4 * fq; const v2u uu = *(const v2u*)up;
        *(v2u*)up = (v2u){pk2(bf2f(uu.x & 0xffff) * (acc[cb][0] + bias), bf2f(uu.x >> 16) * (acc[cb][1] + bias)), pk2(bf2f(uu.y & 0xffff) * (acc[cb][2] + bias), bf2f(uu.y >> 16) * (acc[cb][3] + bias))}; }
    __syncthreads();
}
#define XB_TMO      128
#define XB_XCNT(j)  (256  + 64 * (j))
#define XB_XSUB(j)  (1280 + 64 * (j))
#define XB_XGEN(j)  (2304 + 64 * (j))
#define XB_TOP      3328
#define XB_TOPGEN   3392
#define XCD_BAR_WORDS 3456
#define XB_SPIN_CAP (1u << 18)

__device__ __forceinline__ unsigned xb_ld(unsigned* p)              { return __hip_atomic_load(p, __ATOMIC_RELAXED, __HIP_MEMORY_SCOPE_AGENT); }
__device__ __forceinline__ unsigned xb_add(unsigned* p, unsigned v) { return __hip_atomic_fetch_add(p, v, __ATOMIC_RELAXED, __HIP_MEMORY_SCOPE_AGENT); }
__device__ __forceinline__ unsigned xb_xcc_id() { return (unsigned)__builtin_amdgcn_s_getreg((3 << 11) | 20) & 0xFu; }
#define XB_SPIN(cond, bar) do { unsigned _sp = 0; while (cond) { __builtin_amdgcn_s_sleep(1); \
    if ((++_sp & 255u) == 0u) { if (xb_ld(&(bar)[XB_TMO])) break; if (_sp > XB_SPIN_CAP) { atomicAdd(&(bar)[XB_TMO], 1u); break; } } } } while (0)

struct XcdBarrier {
    unsigned* bar; unsigned x;
    volatile LAS unsigned* st;
};

__device__ __forceinline__ XcdBarrier xcd_barrier_post(unsigned* bar, volatile LAS unsigned* st) {
    XcdBarrier b; b.bar = bar; b.x = xb_xcc_id(); b.st = st;
    if (threadIdx.x == 0) (void)xb_add(&bar[XB_XCNT(b.x)], 1u);
    return b;
}
__device__ __forceinline__ void xcd_barrier_complete(unsigned* bar, unsigned x, unsigned& nloc, unsigned& nx) {
    const unsigned G = gridDim.x * gridDim.y * gridDim.z;
    unsigned sum, cnt, mine, sp = 0u;
    for (;;) {
        sum = 0u; cnt = 0u; mine = 0u;
#pragma unroll
        for (unsigned j = 0; j < 16; ++j) { const unsigned c = xb_ld(&bar[XB_XCNT(j)]); sum += c; cnt += (c > 0u) ? 1u : 0u; mine = (j == x) ? c : mine; }
        if (sum == G) break;
        __builtin_amdgcn_s_sleep(1);
        if ((++sp & 255u) == 0u) { if (xb_ld(&bar[XB_TMO])) break; if (sp > XB_SPIN_CAP) { atomicAdd(&bar[XB_TMO], 1u); break; } }
    }
    nloc = mine > 0u ? mine : 1u; nx = cnt > 0u ? cnt : 1u;
}

__device__ __forceinline__ void xcd_barrier(const XcdBarrier& b) {
    asm volatile("s_waitcnt vmcnt(0)" ::: "memory");
    __syncthreads();
    if (threadIdx.x == 0) {
        unsigned* bar = b.bar;
        __builtin_amdgcn_s_waitcnt(0);
        unsigned nloc = b.st[0], nx = b.st[1];
        if (nloc == 0u) { xcd_barrier_complete(bar, b.x, nloc, nx); b.st[0] = nloc; b.st[1] = nx; }
        const unsigned old = xb_add(&bar[XB_XSUB(b.x)], 1u);
        const unsigned gen = old / nloc;
        if (old + 1u == (gen + 1u) * nloc) {
            __builtin_amdgcn_fence(__ATOMIC_RELEASE, "agent");
            asm volatile("s_waitcnt vmcnt(0)" ::: "memory");
            const unsigned og = xb_add(&bar[XB_TOP], 1u);
            const unsigned tg = og / nx;
            if (og + 1u == (tg + 1u) * nx) xb_add(&bar[XB_TOPGEN], 1u);
            else XB_SPIN(xb_ld(&bar[XB_TOPGEN]) == tg, bar);
            __builtin_amdgcn_fence(__ATOMIC_ACQUIRE, "agent");
            xb_add(&bar[XB_XGEN(b.x)], 1u);
            asm volatile("s_waitcnt vmcnt(0)" ::: "memory");
        } else {
            XB_SPIN(xb_ld(&bar[XB_XGEN(b.x)]) == gen, bar);
            __builtin_amdgcn_fence(__ATOMIC_ACQUIRE, "agent");
            asm volatile("s_waitcnt vmcnt(0)" ::: "memory");
        }
    }
    __syncthreads();
}

constexpr size_t WS_BAR = 65536;
constexpr int LDS_ST_OFF = 131072 + 256;
constexpr int NPH_L = 14, NPH = NPH_L * DEPTH;
#ifndef MK_MULTI
#define MK_MULTI 0
#endif

__global__ void __launch_bounds__(NTHR, 2) fwd_kernel(P p) {
    extern __shared__ __attribute__((aligned(16))) unsigned char lds_raw[];
    LAS unsigned char* lds = (LAS unsigned char*)lds_raw;
    unsigned char* ws = p.ws;
    if (threadIdx.x < 16) ((LAS unsigned*)(lds + LDS_ST_OFF))[threadIdx.x] = 0u;
    __syncthreads();
    XcdBarrier xbar; xbar.bar = (unsigned*)(ws + WS_BAR); xbar.x = 0; xbar.st = (volatile LAS unsigned*)(lds + LDS_ST_OFF);
    bf16* XB = (bf16*)(ws + WS_XB); bf16* H = (bf16*)(ws + WS_H); float* Z = (float*)(ws + WS_Z);
    for (int ph = p.ph_lo; ph < p.ph_hi; ++ph) {
        int tid = threadIdx.x; asm volatile("" : "+v"(tid));
        const int lane = tid & 63, wave = __builtin_amdgcn_readfirstlane(tid >> 6);
        int bid = blockIdx.x; asm volatile("" : "+s"(bid));
        const int G = gridDim.x, gw = bid * NWAVES + wave, NGW = G * NWAVES;
        const int l = ph / NPH_L, q = ph - l * NPH_L;
        if (ph == p.ph_lo) { if (bid == 0) { for (int i = tid; i < XCD_BAR_WORDS; i += NTHR) ((unsigned*)(ws + WS_BAR))[i] = 0u; } }
        if (q == 0) {
            phase_weights(p, l, lds, gw, NGW, wave, lane);
            if (l == 0) phase_x0(p, gw, NGW, lane, tid, bid);
        } else if (q == 1 || q == 11) {
            pg8::Gemm g{XB, (const bf16*)(ws + (q == 1 ? WS_W13A : WS_W13B)), M, 2 * DFF, DM}; pg8::StaticOrder S; S.init(M, 2 * DFF, G, bid);
            pg8::EpiSwiGLU E{H, DFF};
            pg8::gemm_phase<pg8::EpiSwiGLU, pg8::StaticOrder, true, true>(lds, g, S, E, tid);
        } else if (q == 2 || q == 12) {
            pg8::Gemm g{H, (const bf16*)(ws + (q == 2 ? WS_W2A : WS_W2B)), M, DM, DFF}; pg8::StaticOrder S; S.init(M, DM, G, bid);
            pg8::EpiResid E{(ph == 2) ? p.x : p.out, Z, ALPHA, 0.5f};
            pg8::gemm_phase<pg8::EpiResid, pg8::StaticOrder, true, true>(lds, g, S, E, tid);
        } else if (q == 3 || q == 10 || q == 13) {
            const int j = (q == 3) ? 0 : (q == 10 ? 1 : 2);
            phase_ln(Z, p.ln_g + (size_t)(l * 3 + j) * DM, p.ln_b + (size_t)(l * 3 + j) * DM, p.out, XB, gw, NGW, lane);
        } else if (q == 4) {
            pg8::Gemm g{XB, (const bf16*)(ws + WS_WIN), M, DIN, DM}; pg8::StaticOrder S; S.init(M, DIN, G, bid);
            pg8::EpiInProj E{(bf16*)(ws + WS_Q), (bf16*)(ws + WS_KB), (bf16*)(ws + WS_I), (bf16*)(ws + WS_G), (bf16*)(ws + WS_U), (bf16*)(ws + WS_V), (bf16*)(ws + WS_GA), (bf16*)(ws + WS_GB),
                             (float*)(ws + WS_LF), (const float*)(ws + WS_LB) + l * 512};
            pg8::gemm_phase<pg8::EpiInProj, pg8::StaticOrder, true, true>(lds, g, S, E, tid);
        } else if (q == 5) {
            for (int u = bid; u < 1024 + 512; u += G) {
                if (u < 1024) hgrn_p1(lds, u, ws, tid);
                else sgu_unit(lds, u - 1024, ws, p.sg_ln_g + l * 512, p.sg_ln_b + l * 512, p.sg_ws + (size_t)l * 4 * 128 * 128, p.sg_bs + l * 512, tid);
            }
        } else if (q == 6) {
            hgrn_scan(ws, tid, bid, G);
        } else if (q == 7) {
            for (int u = bid; u < 1024; u += G) hgrn_p3(lds, u, ws, p.hg_norm_g + l * 512, tid);
        } else if (q == 8) {
            { pg8::Gemm g{(const bf16*)(ws + WS_G), (const bf16*)(ws + WS_WA), M, DM, 512}; pg8::StaticOrder S; S.init(M, DM, G, bid);
              pg8::EpiBranchA E{(const bf16*)(ws + WS_GA), (float*)(ws + WS_DS)};
              pg8::gemm_phase<pg8::EpiBranchA, pg8::StaticOrder, true, true>(lds, g, S, E, tid); }
            { pg8::Gemm g{(const bf16*)(ws + WS_U), (const bf16*)(ws + WS_WB), M, DM, 512}; pg8::StaticOrder S; S.init(M, DM, G, bid);
              pg8::EpiBranchB E{(bf16*)(ws + WS_GB), (const float*)(ws + WS_DS)};
              pg8::gemm_phase<pg8::EpiBranchB, pg8::StaticOrder, true, true>(lds, g, S, E, tid); }
        } else if (q == 9) {
            pg8::Gemm g{(const bf16*)(ws + WS_GB), (const bf16*)(ws + WS_WOUT), M, DM, DM}; pg8::StaticOrder S; S.init(M, DM, G, bid);
            pg8::EpiResid E{p.out, Z, ALPHA, 1.0f};
            pg8::gemm_phase<pg8::EpiResid, pg8::StaticOrder, true, true>(lds, g, S, E, tid);
        }
        if (ph + 1 < p.ph_hi) {
            if (ph == p.ph_lo) { cg::this_grid().sync(); xbar = xcd_barrier_post((unsigned*)(ws + WS_BAR), (volatile LAS unsigned*)(lds + LDS_ST_OFF)); }
            else xcd_barrier(xbar);
        }
    }
}

extern "C" void kernel_launch(void* const* d_in, const int* in_sizes, int n_in, void* d_out, int out_size, void* d_ws, size_t ws_size, hipStream_t stream) {
    static int grid = 0;
    if (grid == 0) {
        int dev = 0, cus = 0, per_cu = 0;
        if (n_in != 17 || ws_size < WS_END) { fprintf(stderr, "kernel_launch: unexpected inputs (n_in %d, ws %zu)\n", n_in, ws_size); grid = -1; return; }
        (void)hipGetDevice(&dev); (void)hipDeviceGetAttribute(&cus, hipDeviceAttributeMultiprocessorCount, dev);
        if (hipFuncSetAttribute((const void*)fwd_kernel, hipFuncAttributeMaxDynamicSharedMemorySize, LDS_BYTES) != hipSuccess) { fprintf(stderr, "hipFuncSetAttribute failed\n"); grid = -1; return; }
        if (hipOccupancyMaxActiveBlocksPerMultiprocessor(&per_cu, (const void*)fwd_kernel, NTHR, LDS_BYTES) != hipSuccess || per_cu < 1) { fprintf(stderr, "occupancy query: %d\n", per_cu); per_cu = 1; }
        (void)hipGetLastError();
        grid = cus * per_cu;
    }
    if (grid < 0) return;
    P p{};
    p.x = (const float*)d_in[0]; p.ffn1_w13 = (const float*)d_in[1]; p.ffn1_w2 = (const float*)d_in[2]; p.ffn2_w13 = (const float*)d_in[3]; p.ffn2_w2 = (const float*)d_in[4];
    p.ln_g = (const float*)d_in[5]; p.ln_b = (const float*)d_in[6]; p.w_in = (const float*)d_in[7]; p.hg_lb = (const float*)d_in[8]; p.hg_norm_g = (const float*)d_in[9];
    p.sg_ln_g = (const float*)d_in[10]; p.sg_ln_b = (const float*)d_in[11]; p.sg_ws = (const float*)d_in[12]; p.sg_bs = (const float*)d_in[13];
    p.w_a = (const float*)d_in[14]; p.w_b = (const float*)d_in[15]; p.w_out = (const float*)d_in[16];
    p.out = (float*)d_out; p.ws = (unsigned char*)d_ws;
#if MK_MULTI
    for (int ph = 0; ph < NPH; ++ph) { p.ph_lo = ph; p.ph_hi = ph + 1; hipLaunchKernelGGL(fwd_kernel, dim3(grid), dim3(NTHR), LDS_BYTES, stream, p); }
#else
    p.ph_lo = 0; p.ph_hi = NPH;
    void* args[] = {&p};
    hipError_t e = hipLaunchCooperativeKernel((const void*)fwd_kernel, dim3(grid), dim3(NTHR), args, LDS_BYTES, stream);
    if (e != hipSuccess) fprintf(stderr, "cooperative launch failed: %s (grid %d)\n", hipGetErrorString(e), grid);
#endif
}
```
